# Optimizing an MI355X kernel written in HIP

```python
import math
import jax, jax.numpy as jnp
from jax import lax
import numpy as np

D_MODEL = 1024
BATCH = 8
SEQ = 8192
DEPTH = 2

HEAD_DIM = 64
POOL_WINDOWS = (2, 4, 8, 16)
POOL_GROUPS = 4
POOL_GROUP_DIM = 64
POOL_WIDTH = POOL_GROUPS * POOL_GROUP_DIM
DIFF_HEADS = 4
DIFF_V_DIM = 2 * HEAD_DIM
DIFF_QK_WIDTH = DIFF_HEADS * 2 * HEAD_DIM
DIFF_WIDTH = DIFF_HEADS * DIFF_V_DIM
SB_HEADS = 4
SB_WIDTH = SB_HEADS * HEAD_DIM
FOX_HEADS = 4
FOX_WIDTH = FOX_HEADS * HEAD_DIM
N_BRANCHES = 4
BRANCH_WIDTHS = (POOL_WIDTH, DIFF_WIDTH, SB_WIDTH, FOX_WIDTH)
MIX_WIDTH = POOL_WIDTH + DIFF_WIDTH + SB_WIDTH + FOX_WIDTH
IN_SPLITS = (POOL_WIDTH,
             DIFF_QK_WIDTH, DIFF_QK_WIDTH, DIFF_WIDTH,
             SB_WIDTH, SB_WIDTH, SB_WIDTH,
             FOX_WIDTH, FOX_WIDTH, FOX_WIDTH, FOX_HEADS,
             N_BRANCHES * D_MODEL)
D_IN = sum(IN_SPLITS)
D_FF = -(-(8 * D_MODEL) // (3 * 256)) * 256
Q_BLOCK = 128
ROPE_THETA = 10000.0
NORM_EPS = 1e-6

kernel_name = 'hybrid_gated_parallel_mixers'


def _rms_norm(x, gain):
    xf = x.astype(jnp.float32)
    y = xf * lax.rsqrt(jnp.mean(xf * xf, axis=-1, keepdims=True) + NORM_EPS)
    return (y * gain.astype(jnp.float32)).astype(x.dtype)


def _rope(x, positions):
    half = x.shape[-1] // 2
    inv_freq = ROPE_THETA ** (-jnp.arange(half, dtype=jnp.float32) / half)
    ang = positions.astype(jnp.float32)[:, None] * inv_freq[None, :]
    cos, sin = jnp.cos(ang), jnp.sin(ang)
    xf = x.astype(jnp.float32)
    x1, x2 = xf[..., :half], xf[..., half:]
    return jnp.concatenate([x1 * cos - x2 * sin, x2 * cos + x1 * sin], axis=-1).astype(x.dtype)


def _heads(t, n_heads):
    b, s, _ = t.shape
    return t.reshape(b, s, n_heads, -1).transpose(0, 2, 1, 3)


def _block_positions(i, seq_len):
    q_pos = i * Q_BLOCK + jnp.arange(Q_BLOCK)
    k_pos = jnp.arange(seq_len)
    return q_pos[:, None], k_pos[None, :]


def _sweep_query_blocks(block_fn, seq_len):
    out = lax.map(block_fn, jnp.arange(seq_len // Q_BLOCK))
    n_blocks, b, h, qb, dv = out.shape
    return out.transpose(1, 0, 3, 2, 4).reshape(b, n_blocks * qb, h * dv)


def _diff_lambda_init(layer):
    return 0.8 - 0.6 * math.exp(-0.3 * layer)


def _pool_mixer(u, pool_w, pool_scale):
    b, s, _ = u.shape
    uf = u.reshape(b, s, POOL_GROUPS, POOL_GROUP_DIM).astype(jnp.float32)
    csum = jnp.cumsum(uf, axis=1)
    t = jnp.arange(s)
    outs = []
    for g, w in enumerate(POOL_WINDOWS):
        c = csum[:, :, g]
        lagged = jnp.pad(c, ((0, 0), (w, 0), (0, 0)))[:, :s]
        count = jnp.minimum(t + 1, w).astype(jnp.float32)[None, :, None]
        outs.append((c - lagged) / count - uf[:, :, g])
    pooled = jnp.stack(outs, axis=2).astype(u.dtype)
    mixed = jnp.einsum('bsgc,gcd->bsgd', pooled, pool_w)
    return mixed.reshape(b, s, POOL_WIDTH) * pool_scale


def _diff_attention(q, k, v, q_gain, k_gain, subln_gain, lam_q1, lam_k1, lam_q2, lam_k2,
                    lambda_init, positions):
    b, s, _ = q.shape
    q = q.reshape(b, s, DIFF_HEADS, 2, HEAD_DIM).transpose(0, 2, 3, 1, 4)
    k = k.reshape(b, s, DIFF_HEADS, 2, HEAD_DIM).transpose(0, 2, 3, 1, 4)
    q = _rope(_rms_norm(q, q_gain), positions)
    k = _rope(_rms_norm(k, k_gain), positions)
    v = _heads(v, DIFF_HEADS)
    lam = (jnp.exp(jnp.sum(lam_q1.astype(jnp.float32) * lam_k1.astype(jnp.float32)))
           - jnp.exp(jnp.sum(lam_q2.astype(jnp.float32) * lam_k2.astype(jnp.float32)))
           + lambda_init)
    scale = HEAD_DIM ** -0.5

    def block(i):
        qb = lax.dynamic_slice_in_dim(q, i * Q_BLOCK, Q_BLOCK, axis=3)
        logits = jnp.einsum('bhmqd,bhmkd->bhmqk', qb, k).astype(jnp.float32) * scale
        qp, kp = _block_positions(i, s)
        probs = jax.nn.softmax(jnp.where(kp <= qp, logits, -jnp.inf), axis=-1)
        weights = probs[:, :, 0] - lam * probs[:, :, 1]
        return jnp.einsum('bhqk,bhkd->bhqd', weights.astype(v.dtype), v)

    o = _sweep_query_blocks(block, s).reshape(b, s, DIFF_HEADS, DIFF_V_DIM)
    o = _rms_norm(o, subln_gain) * (1.0 - lambda_init)
    return o.reshape(b, s, DIFF_WIDTH)


def _stick_breaking_attention(q, k, v):
    b, s, _ = q.shape
    q, k, v = _heads(q, SB_HEADS), _heads(k, SB_HEADS), _heads(v, SB_HEADS)
    scale = HEAD_DIM ** -0.5

    def block(i):
        qb = lax.dynamic_slice_in_dim(q, i * Q_BLOCK, Q_BLOCK, axis=2)
        z = jnp.einsum('bhqd,bhkd->bhqk', qb, k).astype(jnp.float32) * scale
        qp, kp = _block_positions(i, s)
        strict = kp < qp
        log_not_break = jnp.where(strict, jax.nn.log_sigmoid(-z), 0.0)
        later = lax.cumsum(log_not_break, axis=3, reverse=True) - log_not_break
        weights = jnp.where(strict, jnp.exp(jax.nn.log_sigmoid(z) + later), 0.0)
        return jnp.einsum('bhqk,bhkd->bhqd', weights.astype(v.dtype), v)

    return _sweep_query_blocks(block, s)


def _forgetting_attention(q, k, v, f_logit, b_forget, q_gain, k_gain):
    b, s, _ = q.shape
    q = _rms_norm(_heads(q, FOX_HEADS), q_gain)
    k = _rms_norm(_heads(k, FOX_HEADS), k_gain)
    v = _heads(v, FOX_HEADS)
    log_f = jax.nn.log_sigmoid(f_logit.astype(jnp.float32) + b_forget.astype(jnp.float32))
    cum = jnp.cumsum(log_f, axis=1).transpose(0, 2, 1)
    scale = HEAD_DIM ** -0.5

    def block(i):
        qb = lax.dynamic_slice_in_dim(q, i * Q_BLOCK, Q_BLOCK, axis=2)
        cq = lax.dynamic_slice_in_dim(cum, i * Q_BLOCK, Q_BLOCK, axis=2)
        logits = (jnp.einsum('bhqd,bhkd->bhqk', qb, k).astype(jnp.float32) * scale
                  + cq[..., :, None] - cum[..., None, :])
        qp, kp = _block_positions(i, s)
        probs = jax.nn.softmax(jnp.where(kp <= qp, logits, -jnp.inf), axis=-1)
        return jnp.einsum('bhqk,bhkd->bhqd', probs.astype(v.dtype), v)

    return _sweep_query_blocks(block, s)


def _hybrid_mixer(h, w_in, b_gate, b_forget, pool_w, pool_scale, diff_q_norm, diff_k_norm,
                  diff_subln, lam_q1, lam_k1, lam_q2, lam_k2, fox_q_norm, fox_k_norm,
                  w_branch, w_out, lambda_init, positions):
    b, s, _ = h.shape
    proj = jnp.einsum('bsd,dn->bsn', h, w_in)
    offsets = np.cumsum(IN_SPLITS)[:-1].tolist()
    (u_pool, dq, dk, dv, sq, sk, sv, fq, fk, fv, f_logit, g_logit) = jnp.split(proj, offsets, axis=-1)

    o_pool = _pool_mixer(u_pool, pool_w, pool_scale)
    o_diff = _diff_attention(dq, dk, dv, diff_q_norm, diff_k_norm, diff_subln,
                             lam_q1, lam_k1, lam_q2, lam_k2, lambda_init, positions)
    o_sb = _stick_breaking_attention(sq, sk, sv)
    o_fox = _forgetting_attention(fq, fk, fv, f_logit, b_forget, fox_q_norm, fox_k_norm)

    gates = jax.nn.sigmoid(g_logit.reshape(b, s, N_BRANCHES, D_MODEL) + b_gate)
    row_starts = [0] + np.cumsum(BRANCH_WIDTHS)[:-1].tolist()
    merged = jnp.zeros_like(h)
    for n, o in enumerate((o_pool, o_diff, o_sb, o_fox)):
        w_n = w_branch[row_starts[n]:row_starts[n] + BRANCH_WIDTHS[n]]
        merged = merged + gates[:, :, n] * jnp.einsum('bsc,cd->bsd', o, w_n)
    return jnp.einsum('bsd,de->bse', merged, w_out)


def _swiglu(h, w_up, w_down):
    gate, up = jnp.split(jnp.einsum('bsd,df->bsf', h, w_up), 2, axis=-1)
    return jnp.einsum('bsf,fd->bsd', jax.nn.silu(gate) * up, w_down)


def _normal(k, shape, scale):
    return scale * jax.random.normal(k, shape, jnp.float32)


def setup_inputs(seed: int = 0) -> dict:
    key = jax.random.key(seed)
    ks = jax.random.split(key, 22)
    branch_row_scale = jnp.concatenate(
        [jnp.full((w,), w ** -0.5, jnp.float32) for w in BRANCH_WIDTHS])[:, None]
    return {
        'x': _normal(ks[0], (BATCH, SEQ, D_MODEL), 1.0),
        'attn_norm': 1.0 + _normal(ks[1], (DEPTH, D_MODEL), 0.02),
        'ffn_norm': 1.0 + _normal(ks[2], (DEPTH, D_MODEL), 0.02),
        'w_in': _normal(ks[3], (DEPTH, D_MODEL, D_IN), D_MODEL ** -0.5),
        'b_gate': _normal(ks[4], (DEPTH, N_BRANCHES, D_MODEL), 0.1),
        'b_forget': 3.0 + _normal(ks[5], (DEPTH, FOX_HEADS), 0.5),
        'pool_w': _normal(ks[6], (DEPTH, POOL_GROUPS, POOL_GROUP_DIM, POOL_GROUP_DIM), POOL_GROUP_DIM ** -0.5),
        'pool_scale': 1.0 + _normal(ks[7], (DEPTH, POOL_WIDTH), 0.02),
        'diff_q_norm': 1.0 + _normal(ks[8], (DEPTH, HEAD_DIM), 0.02),
        'diff_k_norm': 1.0 + _normal(ks[9], (DEPTH, HEAD_DIM), 0.02),
        'diff_subln': 1.0 + _normal(ks[10], (DEPTH, DIFF_V_DIM), 0.02),
        'lam_q1': _normal(ks[11], (DEPTH, HEAD_DIM), 0.1),
        'lam_k1': _normal(ks[12], (DEPTH, HEAD_DIM), 0.1),
        'lam_q2': _normal(ks[13], (DEPTH, HEAD_DIM), 0.1),
        'lam_k2': _normal(ks[14], (DEPTH, HEAD_DIM), 0.1),
        'fox_q_norm': 1.0 + _normal(ks[15], (DEPTH, HEAD_DIM), 0.02),
        'fox_k_norm': 1.0 + _normal(ks[16], (DEPTH, HEAD_DIM), 0.02),
        'w_branch': _normal(ks[17], (DEPTH, MIX_WIDTH, D_MODEL), 1.0) * branch_row_scale,
        'w_out': _normal(ks[18], (DEPTH, D_MODEL, D_MODEL), D_MODEL ** -0.5),
        'w_ffn_up': _normal(ks[19], (DEPTH, D_MODEL, 2 * D_FF), D_MODEL ** -0.5),
        'w_ffn_down': _normal(ks[20], (DEPTH, D_FF, D_MODEL), D_FF ** -0.5),
    }


def reference(x, attn_norm, ffn_norm, w_in, b_gate, b_forget, pool_w, pool_scale,
              diff_q_norm, diff_k_norm, diff_subln, lam_q1, lam_k1, lam_q2, lam_k2,
              fox_q_norm, fox_k_norm, w_branch, w_out, w_ffn_up, w_ffn_down):
    positions = jnp.arange(x.shape[1], dtype=jnp.int32)
    for layer in range(DEPTH):
        h = _rms_norm(x, attn_norm[layer])
        x = x + _hybrid_mixer(h, w_in[layer], b_gate[layer], b_forget[layer], pool_w[layer],
                              pool_scale[layer], diff_q_norm[layer], diff_k_norm[layer],
                              diff_subln[layer], lam_q1[layer], lam_k1[layer], lam_q2[layer],
                              lam_k2[layer], fox_q_norm[layer], fox_k_norm[layer],
                              w_branch[layer], w_out[layer], _diff_lambda_init(layer), positions)
        h = _rms_norm(x, ffn_norm[layer])
        x = x + _swiglu(h, w_ffn_up[layer], w_ffn_down[layer])
    return x
```

```cpp
#include <hip/hip_runtime.h>
#include <hip/hip_cooperative_groups.h>
#include <cstdio>
#include <cstdint>
namespace cg = cooperative_groups;

#define LAS __attribute__((address_space(3)))
typedef unsigned short bf16;
typedef short bf16x8 __attribute__((ext_vector_type(8)));
typedef float f32x4 __attribute__((ext_vector_type(4)));
typedef float f32x16 __attribute__((ext_vector_type(16)));
typedef unsigned u32x4 __attribute__((ext_vector_type(4)));
typedef unsigned u32x2 __attribute__((ext_vector_type(2)));
typedef short s16x4 __attribute__((ext_vector_type(4)));
typedef float f32x2_t __attribute__((ext_vector_type(2)));
typedef __bf16 bf16x2_t __attribute__((ext_vector_type(2)));

constexpr int M = 65536, DM = 1024, SEQ = 8192, PW = 3328, DFF = 2816, DIN = 7428, NWAVES = 8;
constexpr float NORM_EPS = 1e-6f, LOG2E = 1.4426950408889634f;
constexpr float C2 = 0.125f * 1.4426950408889634f;
constexpr int C_POOL = 0, C_DQ = 256, C_DK = 768, C_DV = 1280, C_SQ = 1792, C_SK = 2048, C_SV = 2304, C_FQ = 2560, C_FK = 2816, C_FV = 3072;
constexpr size_t MiB = 1u << 20;
constexpr size_t WS_CTL = 0, WS_ROPE = 1 * MiB, WS_LOGF = 3 * MiB, WS_CUM = 4 * MiB, WS_W = 8 * MiB, W_LAYER = 36 * MiB;
constexpr size_t WO_IN = 0, WO_G = 6815744, WO_BR0 = WO_G + 8 * MiB, WO_BR1 = WO_BR0 + 524288, WO_BR2 = WO_BR1 + 1048576, WO_BR3 = WO_BR2 + 524288,
                 WO_OUT = WO_BR3 + 524288, WO_UP = WO_OUT + 2 * MiB, WO_DN = WO_UP + 11 * MiB;
static_assert(WO_DN + (size_t)DM * DFF * 2 <= W_LAYER, "weights");
constexpr size_t WS_H = 80 * MiB, WS_P = 208 * MiB, WS_POOL = 624 * MiB, WS_MERGED = 656 * MiB, WS_STASH = 784 * MiB, WS_END = 912 * MiB;
constexpr size_t STASH_BLK = 524288;
constexpr int LDS_BYTES = 147456, LDS_MISC = 131072;

__device__ __forceinline__ unsigned pk2(float lo, float hi) { f32x2_t v = {lo, hi}; bf16x2_t b = __builtin_convertvector(v, bf16x2_t); return __builtin_bit_cast(unsigned, b); }
__device__ __forceinline__ float bflo(unsigned w) { return __uint_as_float(w << 16); }
__device__ __forceinline__ float bfhi(unsigned w) { return __uint_as_float(w & 0xffff0000u); }
__device__ __forceinline__ float wave_sum(float v) {
#pragma unroll
    for (int o = 1; o < 64; o <<= 1) v += __shfl_xor(v, o);
    return v;
}
__device__ __forceinline__ float max3f(float a, float b, float c) { float r; asm("v_max3_f32 %0, %1, %2, %3" : "=v"(r) : "v"(a), "v"(b), "v"(c)); return r; }
__device__ __forceinline__ float fadd_v(float a, float b) { float r; asm volatile("v_add_f32_e32 %0, %1, %2" : "=v"(r) : "v"(a), "v"(b)); return r; }
__device__ __forceinline__ float partner32(float v) {
    auto rr = __builtin_amdgcn_permlane32_swap(__float_as_uint(v), __float_as_uint(v), false, false);
    return (threadIdx.x & 32) ? __uint_as_float(rr[0]) : __uint_as_float(rr[1]);
}

__device__ __forceinline__ int tid_l() { int t = threadIdx.x; asm volatile("" : "+v"(t)); return t; }
namespace pg8 {
constexpr int BM = 256, BK = 64, HALF = 128, HTB = HALF * BK * 2, STAGE_BYTES = 8 * HTB, NXCD = 8, WGM = 8;
__host__ __device__ __forceinline__ int lds_byte(int r, int c) { const int st = (r >> 4) * 2 + (c >> 5), rr = r & 15, cc = c & 31, ob = rr * 64 + cc * 2; return st * 1024 + (ob ^ (((ob >> 9) & 1) << 5)); }
__host__ __device__ __forceinline__ void stage_rc(int b, int& R, int& C) { const int st = b / 1024, sb = b % 1024, swz = sb ^ (((sb >> 9) & 1) << 5); R = (st >> 1) * 16 + swz / 64; C = (st & 1) * 32 + (swz % 64) / 2; }
__host__ __device__ __forceinline__ int perm32(int rho) { const int n = rho >> 4, i = rho & 15; return 8 * (i >> 2) + 4 * n + (i & 3); }

struct Unit { const char* A; const char* B; int lda2, ldb2, nt, pm, pn, mode; };

struct TileOrder {
    int nM, nN, nwg, G, c;
    __device__ void init(int nM_, int nN_, int G_, int c_) { nM = nM_; nN = nN_; nwg = nM * nN; G = G_; c = c_; }
    __device__ bool get(int i, int& pm, int& pn) const {
        const long L = (long)i * G + c; if (L >= nwg) return false;
        int wgid = (int)L; { const int q = nwg / NXCD, r = nwg % NXCD, xcd = wgid % NXCD, off = wgid / NXCD; wgid = (xcd < r ? xcd * (q + 1) : r * (q + 1) + (xcd - r) * q) + off; }
        const int nig = WGM * nN, gid = wgid / nig, fm = gid * WGM, gsz = (nM - fm) < WGM ? (nM - fm) : WGM;
        pm = fm + ((wgid % nig) % gsz); pn = (wgid % nig) / gsz; return true;
    }
};

template <class Epi, class Sched>
__device__ __forceinline__ void gemm_phase(LAS unsigned char* lds, const Sched& S, const Epi& E) {
    const int tid = tid_l(), wid = __builtin_amdgcn_readfirstlane(tid >> 6), lane = tid & 63, wr = wid >> 2, wc = wid & 3, fr = lane & 15, fq = lane >> 4;
    unsigned rA[2], rB[2], cc2[2];
#pragma unroll
    for (int i = 0; i < 2; ++i) { int R, C; stage_rc(tid * 16 + i * 8192, R, C); rA[i] = (unsigned)R; rB[i] = (unsigned)((R & ~31) + perm32(R & 31)); cc2[i] = (unsigned)C * 2u; }
    const unsigned ldsw = (unsigned)wid * 1024u;
    const int aoff = lds_byte(wr * 64 + fr, fq * 8), boff = lds_byte(wc * 32 + fr, fq * 8);
#define PG8_SA(b, h) (((b) * 2 + (h)) * HTB)
#define PG8_SB(b, h) ((4 + (b) * 2 + (h)) * HTB)
#define PG8_STAGE(bufoff, gbase, rr, pitch) do { _Pragma("unroll") for (int _i = 0; _i < 2; ++_i) \
        __builtin_amdgcn_global_load_lds((const unsigned*)((const char*)(gbase) + (size_t)((rr)[_i] * (unsigned)(pitch) + cc2[_i])), (LAS unsigned*)(lds + (bufoff) + ldsw + _i * 8192), 16, 0, 0); } while (0)
#define PG8_LDA(dst, b, h) do { _Pragma("unroll") for (int m = 0; m < 4; ++m) _Pragma("unroll") for (int k = 0; k < 2; ++k) dst[m][k] = *(const LAS bf16x8*)(lds + PG8_SA(b, h) + aoff + m * 2048 + k * 1024); } while (0)
#define PG8_LDB(dst, b, h) do { _Pragma("unroll") for (int n = 0; n < 2; ++n) _Pragma("unroll") for (int k = 0; k < 2; ++k) dst[n][k] = *(const LAS bf16x8*)(lds + PG8_SB(b, h) + boff + n * 2048 + k * 1024); } while (0)
#define PG8_MMA(ai, bj, At, Bt) do { __builtin_amdgcn_s_setprio(1); _Pragma("unroll") for (int m = 0; m < 4; ++m) _Pragma("unroll") for (int n = 0; n < 2; ++n) _Pragma("unroll") for (int k = 0; k < 2; ++k) \
        acc[ai][bj][m][n] = __builtin_amdgcn_mfma_f32_16x16x32_bf16(Bt[n][k], At[m][k], acc[ai][bj][m][n], 0, 0, 0); __builtin_amdgcn_s_setprio(0); } while (0)
#define PG8_WAIT_V(n) asm volatile("s_waitcnt vmcnt(" #n ")" ::: "memory")
#define PG8_WAIT_L(n) asm volatile("s_waitcnt lgkmcnt(" #n ")" ::: "memory")
#define PG8_BAR __builtin_amdgcn_s_barrier()
#define PG8_SCHED __builtin_amdgcn_sched_barrier(0)
    Unit cur, nxt; int ui = 0;
    if (!S.next(0, cur)) return;
    f32x4 acc[2][2][4][2];
#pragma unroll
    for (int a = 0; a < 2; ++a)
#pragma unroll
        for (int b = 0; b < 2; ++b)
#pragma unroll
            for (int m = 0; m < 4; ++m)
#pragma unroll
                for (int n = 0; n < 2; ++n) acc[a][b][m][n] = (f32x4){0.f, 0.f, 0.f, 0.f};
    bf16x8 At[4][2], B0[2][2], B1[2][2];
    {
        const char* cA = cur.A; const char* cB = cur.B; const int pa = cur.lda2, pb = cur.ldb2;
        PG8_STAGE(PG8_SB(0, 0), cB, rB, pb); PG8_STAGE(PG8_SB(0, 1), cB + (size_t)HALF * pb, rB, pb); PG8_STAGE(PG8_SA(0, 0), cA, rA, pa); PG8_STAGE(PG8_SA(0, 1), cA + (size_t)HALF * pa, rA, pa);
        if (wr == 1) PG8_BAR;
        PG8_WAIT_V(2); PG8_BAR;
        PG8_STAGE(PG8_SB(1, 0), cB + 128, rB, pb); PG8_STAGE(PG8_SA(1, 0), cA + 128, rA, pa); PG8_STAGE(PG8_SB(1, 1), cB + (size_t)HALF * pb + 128, rB, pb);
        PG8_WAIT_V(6); PG8_BAR;
    }
    for (;;) {
        const bool has_next = S.next(ui + 1, nxt);
        if (!has_next) nxt = cur;
        const char* cA = cur.A; const char* cB = cur.B; const int cpa = cur.lda2, cpb = cur.ldb2, nt = cur.nt;
        for (int t = 0; t < nt; t += 2) {
            const bool last = (t == nt - 2);
            const char* a1 = cA + (size_t)(t + 1) * 128;
            const char* a2 = last ? nxt.A : cA + (size_t)(t + 2) * 128; const char* b2 = last ? nxt.B : cB + (size_t)(t + 2) * 128;
            const int pa2 = last ? nxt.lda2 : cpa, pb2 = last ? nxt.ldb2 : cpb;
            const char* a3 = a2 + 128; const char* b3 = b2 + 128;
            PG8_LDB(B0, 0, 0); PG8_LDB(B1, 0, 1); PG8_SCHED; PG8_LDA(At, 0, 0); PG8_STAGE(PG8_SA(1, 1), a1 + (size_t)HALF * cpa, rA, cpa);
            PG8_WAIT_V(8); PG8_WAIT_L(0); PG8_BAR; PG8_MMA(0, 0, At, B0); PG8_MMA(0, 1, At, B1); PG8_BAR; PG8_SCHED;
            PG8_LDA(At, 0, 1); PG8_STAGE(PG8_SB(0, 0), b2, rB, pb2); PG8_STAGE(PG8_SB(0, 1), b2 + (size_t)HALF * pb2, rB, pb2); PG8_STAGE(PG8_SA(0, 0), a2, rA, pa2);
            PG8_WAIT_V(8); PG8_WAIT_L(0); PG8_BAR; PG8_MMA(1, 0, At, B0); PG8_MMA(1, 1, At, B1); PG8_BAR; PG8_SCHED;
            PG8_LDB(B0, 1, 0); PG8_LDB(B1, 1, 1); PG8_SCHED; PG8_LDA(At, 1, 0); PG8_STAGE(PG8_SA(0, 1), a2 + (size_t)HALF * pa2, rA, pa2);
            PG8_WAIT_V(8); PG8_WAIT_L(0); PG8_BAR; PG8_MMA(0, 0, At, B0); PG8_MMA(0, 1, At, B1); PG8_BAR; PG8_SCHED;
            PG8_LDA(At, 1, 1); PG8_STAGE(PG8_SB(1, 0), b3, rB, pb2); PG8_STAGE(PG8_SB(1, 1), b3 + (size_t)HALF * pb2, rB, pb2); PG8_STAGE(PG8_SA(1, 0), a3, rA, pa2);
            PG8_WAIT_V(8); PG8_WAIT_L(0); PG8_BAR; PG8_MMA(1, 0, At, B0); PG8_MMA(1, 1, At, B1); PG8_BAR; PG8_SCHED;
        }
        if (wr == 0) PG8_BAR;
        E(acc, cur, wr, wc, fr, fq);
        if (!has_next) break;
        if (!Epi::SELF_ZERO) {
#pragma unroll
        for (int a = 0; a < 2; ++a)
#pragma unroll
            for (int b = 0; b < 2; ++b)
#pragma unroll
                for (int m = 0; m < 4; ++m)
#pragma unroll
                    for (int n = 0; n < 2; ++n) acc[a][b][m][n] = (f32x4){0.f, 0.f, 0.f, 0.f};
        }
        cur = nxt; ++ui;
        if (wr == 1) PG8_BAR;
    }
    PG8_WAIT_V(0);
    PG8_BAR;
#undef PG8_SA
#undef PG8_SB
#undef PG8_STAGE
#undef PG8_LDA
#undef PG8_LDB
#undef PG8_MMA
#undef PG8_WAIT_V
#undef PG8_WAIT_L
#undef PG8_BAR
#undef PG8_SCHED
}

struct SimpleSched {
    const char* A; const char* B; int lda2, ldb2, nt; TileOrder ord;
    __device__ __forceinline__ bool next(int i, Unit& u) const {
        int pm, pn; if (!ord.get(i, pm, pn)) return false;
        u.A = A + (size_t)pm * 256 * lda2; u.B = B + (size_t)pn * 256 * ldb2; u.lda2 = lda2; u.ldb2 = ldb2; u.nt = nt; u.pm = pm; u.pn = pn; u.mode = 0; return true;
    }
};
struct MergeSched {
    const char* H; const char* P; const char* POOL; const char* wl; TileOrder ord;
    __device__ __forceinline__ bool next(int i, Unit& u) const {
        int pm, pn; if (!ord.get(i >> 3, pm, pn)) return false;
        const int s = i & 7, n = s & 3;
        u.pm = pm; u.pn = pn; u.mode = s;
        if (s < 4) { u.A = H + (size_t)pm * 256 * 2048; u.lda2 = 2048; u.B = wl + WO_G + (size_t)(n * 1024 + pn * 256) * 2048; u.ldb2 = 2048; u.nt = 16; }
        else if (n == 0) { u.A = POOL + (size_t)pm * 256 * 512; u.lda2 = 512; u.B = wl + WO_BR0 + (size_t)pn * 256 * 512; u.ldb2 = 512; u.nt = 4; }
        else {
            const int col = n == 1 ? C_DQ : (n == 2 ? C_SQ : C_FQ), K = n == 1 ? 512 : 256;
            const char* wb = wl + (n == 1 ? WO_BR1 : (n == 2 ? WO_BR2 : WO_BR3));
            u.A = P + (size_t)pm * 256 * (PW * 2) + col * 2; u.lda2 = PW * 2; u.B = wb + (size_t)pn * 256 * (K * 2); u.ldb2 = K * 2; u.nt = K / 64;
        }
        return true;
    }
};

struct EpiStore {
    static constexpr bool SELF_ZERO = false;
    bf16* O; int ldc;
    __device__ __forceinline__ bool operator()(f32x4 (&acc)[2][2][4][2], const Unit& u, int wr, int wc, int fr, int fq) const {
        const int row0 = u.pm * BM + wr * 64 + fr, col0 = u.pn * BM + wc * 32 + 8 * fq;
#pragma unroll
        for (int ai = 0; ai < 2; ++ai)
#pragma unroll
            for (int m = 0; m < 4; ++m) { bf16* rowp = O + (size_t)(row0 + ai * HALF + m * 16) * ldc + col0;
#pragma unroll
                for (int bj = 0; bj < 2; ++bj) { const f32x4 v0 = acc[ai][bj][m][0], v1 = acc[ai][bj][m][1];
                    u32x4 w; w.x = pk2(v0[0], v0[1]); w.y = pk2(v0[2], v0[3]); w.z = pk2(v1[0], v1[1]); w.w = pk2(v1[2], v1[3]);
                    *(u32x4*)(rowp + bj * HALF) = w; } }
        return false;
    }
};
struct EpiResid {
    static constexpr bool SELF_ZERO = false;
    const float* base; float* out;
    __device__ __forceinline__ bool operator()(f32x4 (&acc)[2][2][4][2], const Unit& u, int wr, int wc, int fr, int fq) const {
        const int row0 = u.pm * BM + wr * 64 + fr, col0 = u.pn * BM + wc * 32 + 8 * fq;
#pragma unroll
        for (int ai = 0; ai < 2; ++ai)
#pragma unroll
            for (int m = 0; m < 4; ++m) { const size_t off = (size_t)(row0 + ai * HALF + m * 16) * DM + col0;
#pragma unroll
                for (int bj = 0; bj < 2; ++bj)
#pragma unroll
                    for (int n = 0; n < 2; ++n) { const f32x4 b = *(const f32x4*)(base + off + bj * HALF + 4 * n); *(f32x4*)(out + off + bj * HALF + 4 * n) = b + acc[ai][bj][m][n]; } }
        return false;
    }
};
struct EpiSwiGLU {
    static constexpr bool SELF_ZERO = false;
    bf16* Hf;
    __device__ __forceinline__ bool operator()(f32x4 (&acc)[2][2][4][2], const Unit& u, int wr, int wc, int fr, int fq) const {
        const int row0 = u.pm * BM + wr * 64 + fr, col0 = u.pn * HALF + wc * 32 + 8 * fq;
#pragma unroll
        for (int ai = 0; ai < 2; ++ai)
#pragma unroll
            for (int m = 0; m < 4; ++m) { unsigned w[4];
#pragma unroll
                for (int n = 0; n < 2; ++n) { const f32x4 g = acc[ai][0][m][n], up = acc[ai][1][m][n]; float r[4];
#pragma unroll
                    for (int j = 0; j < 4; ++j) r[j] = g[j] * up[j] * __builtin_amdgcn_rcpf(1.0f + __builtin_amdgcn_exp2f(-g[j] * LOG2E));
                    w[2 * n] = pk2(r[0], r[1]); w[2 * n + 1] = pk2(r[2], r[3]); }
                *(u32x4*)(Hf + (size_t)(row0 + ai * HALF + m * 16) * DFF + col0) = (u32x4){w[0], w[1], w[2], w[3]}; }
        return false;
    }
};
struct EpiMerge {
    static constexpr bool SELF_ZERO = true;
    const float* b_gate; u32x4* gst; bf16* merged;
    __device__ __forceinline__ bool operator()(f32x4 (&acc)[2][2][4][2], const Unit& u, int wr, int wc, int fr, int fq) const {
        const int tid = tid_l(), n_br = u.mode & 3;
        const bool gate = u.mode < 4, last = u.mode == 7;
        const float keepf = (!gate && !last) ? 1.0f : 0.0f;
        const int row0 = u.pm * BM + wr * 64 + fr, col0 = u.pn * BM + wc * 32 + 8 * fq;
        f32x4 bv[2][2];
#pragma unroll
        for (int bj = 0; bj < 2; ++bj)
#pragma unroll
            for (int n = 0; n < 2; ++n) bv[bj][n] = gate ? *(const f32x4*)(b_gate + n_br * DM + col0 + bj * HALF + 4 * n) : (f32x4){0.f, 0.f, 0.f, 0.f};
        u32x4* gp = gst + n_br * 8192 + tid;
#pragma unroll
        for (int ai = 0; ai < 2; ++ai)
#pragma unroll
            for (int m = 0; m < 4; ++m)
#pragma unroll
                for (int bj = 0; bj < 2; ++bj) {
                    f32x4 s0 = {1.f, 1.f, 1.f, 1.f}, s1 = {1.f, 1.f, 1.f, 1.f};
                    if (gate) { unsigned w[4];
#pragma unroll
                        for (int n = 0; n < 2; ++n) { const f32x4 v = acc[ai][bj][m][n] + bv[bj][n]; float r[4];
#pragma unroll
                            for (int j = 0; j < 4; ++j) r[j] = fmaxf(__builtin_amdgcn_rcpf(1.0f + __builtin_amdgcn_exp2f(-v[j] * LOG2E)), 1e-30f);
                            w[2 * n] = pk2(r[0], r[1]); w[2 * n + 1] = pk2(r[2], r[3]); }
                        *gp = (u32x4){w[0], w[1], w[2], w[3]};
                    } else {
                        const u32x4 g = *gp;
                        u32x4 h = {0x3f803f80u, 0x3f803f80u, 0x3f803f80u, 0x3f803f80u};
                        if (!last) { const u32x4* gq = gp + 8192; h = *gq; }
                        s0 = (f32x4){bflo(g.x) * __builtin_amdgcn_rcpf(bflo(h.x)), bfhi(g.x) * __builtin_amdgcn_rcpf(bfhi(h.x)), bflo(g.y) * __builtin_amdgcn_rcpf(bflo(h.y)), bfhi(g.y) * __builtin_amdgcn_rcpf(bfhi(h.y))};
                        s1 = (f32x4){bflo(g.z) * __builtin_amdgcn_rcpf(bflo(h.z)), bfhi(g.z) * __builtin_amdgcn_rcpf(bfhi(h.z)), bflo(g.w) * __builtin_amdgcn_rcpf(bflo(h.w)), bfhi(g.w) * __builtin_amdgcn_rcpf(bfhi(h.w))};
                    }
                    const f32x4 v0 = acc[ai][bj][m][0] * s0, v1 = acc[ai][bj][m][1] * s1;
                    if (last) { u32x4 w; w.x = pk2(v0[0], v0[1]); w.y = pk2(v0[2], v0[3]); w.z = pk2(v1[0], v1[1]); w.w = pk2(v1[2], v1[3]);
                                *(u32x4*)(merged + (size_t)(row0 + ai * HALF + m * 16) * DM + col0 + bj * HALF) = w; }
                    acc[ai][bj][m][0] = v0 * keepf; acc[ai][bj][m][1] = v1 * keepf;
                    gp += 512; asm volatile("" : "+v"(gp), "+v"(acc[ai][bj][m][0]), "+v"(acc[ai][bj][m][1]) :: "memory"); }
        return false;
    }
};
}

__device__ __forceinline__ void transpose_item(const float* W, int ldw, int k0, int c0, bf16* WT, int ldk, int r0, float scale, LAS float* scr, int lane) {
#pragma unroll
    for (int i = 0; i < 32; ++i) { const int kk = 2 * i + (lane >> 5); scr[kk * 33 + (lane & 31)] = W[(size_t)(k0 + kk) * ldw + c0 + (lane & 31)] * scale; }
    asm volatile("s_waitcnt lgkmcnt(0)" ::: "memory");
    const int c = lane & 7;
#pragma unroll
    for (int j = 0; j < 4; ++j) { const int n = (lane >> 3) + 8 * j; const LAS float* s = scr + (8 * c) * 33 + n;
        u32x4 o; o.x = pk2(s[0 * 33], s[1 * 33]); o.y = pk2(s[2 * 33], s[3 * 33]); o.z = pk2(s[4 * 33], s[5 * 33]); o.w = pk2(s[6 * 33], s[7 * 33]);
        *(u32x4*)(WT + (size_t)(r0 + n) * ldk + k0 + 8 * c) = o; }
    asm volatile("s_waitcnt lgkmcnt(0)" ::: "memory");
}

struct Args { const float* in[21]; float* out; unsigned char* ws; };
typedef const __attribute__((address_space(4))) Args* ArgsP;
__device__ __forceinline__ ArgsP get_args() { ArgsP p = (ArgsP)__builtin_amdgcn_kernarg_segment_ptr(); asm volatile("" : "+s"(p)); return p; }
enum { I_X = 0, I_ANORM, I_FNORM, I_WIN, I_BGATE, I_BFORGET, I_POOLW, I_POOLS, I_DQN, I_DKN, I_SUBLN, I_LQ1, I_LK1, I_LQ2, I_LK2, I_FQN, I_FKN, I_WBR, I_WOUT, I_WUP, I_WDN };

__device__ __forceinline__ void prologue(LAS unsigned char* lds) {
    const ArgsP ap = get_args();
    const int tid = tid_l(), lane = tid & 63, wave = __builtin_amdgcn_readfirstlane(tid >> 6), gw = blockIdx.x * NWAVES + wave, NGW = gridDim.x * NWAVES;
    LAS float* scr = (LAS float*)(lds + wave * 16384);
    constexpr int N_IN = 16 * 104, N_G = 16 * 128, N_B1 = 8 * 32, N_B2 = 4 * 32, N_B3 = 4 * 32, N_O = 16 * 32, N_UP = 16 * 176, N_DN = 44 * 32;
    constexpr int N_L = N_IN + N_G + N_B1 + N_B2 + N_B3 + N_O + N_UP + N_DN;
    for (int it = gw; it < 2 * N_L; it += NGW) {
        const int l = it / N_L; int r = it % N_L;
        unsigned char* wl = ap->ws + WS_W + (size_t)l * W_LAYER;
        const float* win = ap->in[I_WIN] + (size_t)l * DM * DIN;
        if (r < N_IN) { const int kb = r / 104, nb = r % 104, c0 = nb * 32; const float sc = (c0 >= C_SQ && c0 < C_SK) ? C2 : 1.0f;
            transpose_item(win, DIN, kb * 64, c0, (bf16*)(wl + WO_IN), DM, c0, sc, scr, lane); continue; } r -= N_IN;
        if (r < N_G) { const int kb = r / 128, nb = r % 128; transpose_item(win, DIN, kb * 64, 3332 + nb * 32, (bf16*)(wl + WO_G), DM, nb * 32, 1.0f, scr, lane); continue; } r -= N_G;
        const float* wbr = ap->in[I_WBR] + (size_t)l * 1280 * DM;
        if (r < N_B1) { const int kb = r / 32, nb = r % 32; transpose_item(wbr + (size_t)256 * DM, DM, kb * 64, nb * 32, (bf16*)(wl + WO_BR1), 512, nb * 32, 1.0f, scr, lane); continue; } r -= N_B1;
        if (r < N_B2) { const int kb = r / 32, nb = r % 32; transpose_item(wbr + (size_t)768 * DM, DM, kb * 64, nb * 32, (bf16*)(wl + WO_BR2), 256, nb * 32, 1.0f, scr, lane); continue; } r -= N_B2;
        if (r < N_B3) { const int kb = r / 32, nb = r % 32; transpose_item(wbr + (size_t)1024 * DM, DM, kb * 64, nb * 32, (bf16*)(wl + WO_BR3), 256, nb * 32, 1.0f, scr, lane); continue; } r -= N_B3;
        if (r < N_O) { const int kb = r / 32, nb = r % 32; transpose_item(ap->in[I_WOUT] + (size_t)l * DM * DM, DM, kb * 64, nb * 32, (bf16*)(wl + WO_OUT), DM, nb * 32, 1.0f, scr, lane); continue; } r -= N_O;
        if (r < N_UP) { const int kb = r / 176, nb = r % 176, c0 = nb * 32;
            const int isup = c0 >= DFF, f = isup ? c0 - DFF : c0, r0 = (f >> 7) * 256 + isup * 128 + (f & 127);
            transpose_item(ap->in[I_WUP] + (size_t)l * DM * 2 * DFF, 2 * DFF, kb * 64, c0, (bf16*)(wl + WO_UP), DM, r0, 1.0f, scr, lane); continue; } r -= N_UP;
        { const int kb = r / 32, nb = r % 32; transpose_item(ap->in[I_WDN] + (size_t)l * DFF * DM, DM, kb * 64, nb * 32, (bf16*)(wl + WO_DN), DFF, nb * 32, 1.0f, scr, lane); }
    }
    const int gt = gw * 64 + lane, NGT = NGW * 64;
    for (int it = gt; it < 2 * 4 * 8 * 1024; it += NGT) {
        const int e = it & 1023, cb = (it >> 10) & 7, g = (it >> 13) & 3, l = it >> 15;
        const float* wb = ap->in[I_WBR] + (size_t)l * 1280 * DM + (size_t)(g * 64) * DM + e;
        const float* ps = ap->in[I_POOLS] + l * 256 + g * 64;
        float wk[64];
#pragma unroll
        for (int k = 0; k < 64; ++k) wk[k] = wb[(size_t)k * DM] * ps[k];
        const float* pw = ap->in[I_POOLW] + (size_t)l * 16384 + (size_t)(g * 64 + cb * 8) * 64;
        float r8[8];
#pragma unroll
        for (int c = 0; c < 8; ++c) { float acc = 0.f;
#pragma unroll
            for (int k = 0; k < 64; ++k) acc += pw[c * 64 + k] * wk[k];
            r8[c] = acc; }
        u32x4 o; o.x = pk2(r8[0], r8[1]); o.y = pk2(r8[2], r8[3]); o.z = pk2(r8[4], r8[5]); o.w = pk2(r8[6], r8[7]);
        *(u32x4*)((bf16*)(ap->ws + WS_W + (size_t)l * W_LAYER + WO_BR0) + (size_t)e * 256 + g * 64 + cb * 8) = o;
    }
    float* rope = (float*)(ap->ws + WS_ROPE);
    for (int it = gt; it < SEQ * 32; it += NGT) {
        const int pos = it >> 5, i = it & 31;
        const float inv_freq = exp2f(-(float)i * (13.287712379549449f / 32.0f));
        const float ang = (float)pos * inv_freq;
        const double kq = rint((double)ang * 0.15915494309189535);
        const float red = (float)((double)ang - kq * 6.283185307179586);
        rope[it * 2] = cosf(red); rope[it * 2 + 1] = sinf(red);
    }
}

template <bool FL>
__device__ __forceinline__ void norm_phase(const float* x, const float* gain, bf16* H, const float* win_l, const float* b_forget, float* logf) {
    const int tid = tid_l(), lane = tid & 63, wave = __builtin_amdgcn_readfirstlane(tid >> 6), gw = blockIdx.x * NWAVES + wave, NGW = gridDim.x * NWAVES;
    f32x4 g[4];
#pragma unroll
    for (int j = 0; j < 4; ++j) g[j] = *(const f32x4*)(gain + 4 * lane + 256 * j);
    f32x4 wf[4][4];
    if (FL) {
#pragma unroll
        for (int j = 0; j < 4; ++j)
#pragma unroll
            for (int e = 0; e < 4; ++e) { const int col = 4 * lane + 256 * j + e; wf[j][e] = *(const f32x4*)(win_l + (size_t)col * DIN + 3328) * g[j][e]; }
    }
    f32x4 v[2][4];
#pragma unroll
    for (int u = 0; u < 2; ++u) { const f32x4* xr = (const f32x4*)(x + (size_t)(gw * 2 + u) * DM) + lane;
#pragma unroll
        for (int j = 0; j < 4; ++j) v[u][j] = xr[64 * j]; }
    for (int m0 = gw * 2; m0 < M; m0 += NGW * 2) {
        f32x4 vn[2][4];
        const int mn = (m0 + NGW * 2 < M) ? m0 + NGW * 2 : m0;
#pragma unroll
        for (int u = 0; u < 2; ++u) { const f32x4* xr = (const f32x4*)(x + (size_t)(mn + u) * DM) + lane;
#pragma unroll
            for (int j = 0; j < 4; ++j) vn[u][j] = xr[64 * j]; }
#pragma unroll
        for (int u = 0; u < 2; ++u) {
            const int m = m0 + u;
            float ss = 0.f;
#pragma unroll
            for (int j = 0; j < 4; ++j) ss += (v[u][j].x * v[u][j].x + v[u][j].y * v[u][j].y) + (v[u][j].z * v[u][j].z + v[u][j].w * v[u][j].w);
            ss = wave_sum(ss);
            const float rstd = 1.0f / sqrtf(ss * (1.0f / DM) + NORM_EPS);
            unsigned long long* o8 = (unsigned long long*)(H + (size_t)m * DM) + lane;
#pragma unroll
            for (int j = 0; j < 4; ++j) { const f32x4 t = v[u][j] * rstd * g[j]; o8[64 * j] = (unsigned long long)pk2(t.x, t.y) | ((unsigned long long)pk2(t.z, t.w) << 32); }
            if (FL) {
                f32x4 d = {0.f, 0.f, 0.f, 0.f};
#pragma unroll
                for (int j = 0; j < 4; ++j)
#pragma unroll
                    for (int e = 0; e < 4; ++e) d = d + wf[j][e] * v[u][j][e];
                d.x = wave_sum(d.x); d.y = wave_sum(d.y); d.z = wave_sum(d.z); d.w = wave_sum(d.w);
                if (lane < 4) {
                    const float dz = lane == 0 ? d.x : (lane == 1 ? d.y : (lane == 2 ? d.z : d.w));
                    const float z = dz * rstd + b_forget[lane];
                    logf[(size_t)m * 4 + lane] = fminf(z, 0.f) - log1pf(expf(-fabsf(z)));
                }
            }
        }
#pragma unroll
        for (int u = 0; u < 2; ++u)
#pragma unroll
            for (int j = 0; j < 4; ++j) v[u][j] = vn[u][j];
    }
}

__device__ __forceinline__ void e1_phase(int layer, LAS unsigned char* lds) {
    const ArgsP ap = get_args();
    const int tid = tid_l(), gt = blockIdx.x * 512 + tid, NGT = gridDim.x * 512;
    bf16* P = (bf16*)(ap->ws + WS_P);
    const float* rope = (const float*)(ap->ws + WS_ROPE);
    {
        const int lane = tid & 63, hvl = lane >> 3, ch = lane & 7;
        const int gwv = blockIdx.x * NWAVES + (tid >> 6), NGWV = gridDim.x * NWAVES;
        for (int it0 = gwv * 4; it0 < M * 3; it0 += NGWV * 4) {
            u32x4 wv[4];
#pragma unroll
            for (int u = 0; u < 4; ++u) { const int it = it0 + u, m = it / 3, seg = it - m * 3; const int col = seg == 0 ? C_DQ : (seg == 1 ? C_DK : C_FQ);
                wv[u] = *((const u32x4*)(P + (size_t)m * PW + col) + lane); }
#pragma unroll
            for (int u = 0; u < 4; ++u) {
                const int it = it0 + u, m = it / 3, seg = it - m * 3, pos = m & (SEQ - 1);
                const int col = seg == 0 ? C_DQ : (seg == 1 ? C_DK : C_FQ);
                const float* gn = seg == 0 ? ap->in[I_DQN] : (seg == 1 ? ap->in[I_DKN] : (hvl < 4 ? ap->in[I_FQN] : ap->in[I_FKN]));
                const float sc = seg == 0 ? C2 : (seg == 1 ? 1.0f : (hvl < 4 ? C2 : 1.0f));
                const u32x4 w = wv[u];
                float v[8] = {bflo(w.x), bfhi(w.x), bflo(w.y), bfhi(w.y), bflo(w.z), bfhi(w.z), bflo(w.w), bfhi(w.w)};
                float ss = 0.f;
#pragma unroll
                for (int j = 0; j < 8; ++j) ss += v[j] * v[j];
                ss += __shfl_xor(ss, 1); ss += __shfl_xor(ss, 2); ss += __shfl_xor(ss, 4);
                const float rs = 1.0f / sqrtf(ss * (1.0f / 64.0f) + NORM_EPS);
                const f32x4 g0 = *(const f32x4*)(gn + layer * 64 + ch * 8), g1 = *(const f32x4*)(gn + layer * 64 + ch * 8 + 4);
                v[0] *= rs * g0.x; v[1] *= rs * g0.y; v[2] *= rs * g0.z; v[3] *= rs * g0.w; v[4] *= rs * g1.x; v[5] *= rs * g1.y; v[6] *= rs * g1.z; v[7] *= rs * g1.w;
                if (seg < 2) {
                    const f32x4* rp = (const f32x4*)(rope + (size_t)pos * 64 + (ch & 3) * 16);
                    const float sgn = ch < 4 ? -1.0f : 1.0f;
#pragma unroll
                    for (int j = 0; j < 8; j += 2) { const f32x4 cs = rp[j >> 1];
                        const float p0 = __shfl_xor(v[j], 4), p1 = __shfl_xor(v[j + 1], 4);
                        v[j] = v[j] * cs.x + sgn * p0 * cs.y; v[j + 1] = v[j + 1] * cs.z + sgn * p1 * cs.w; }
                }
                u32x4 o; o.x = pk2(v[0] * sc, v[1] * sc); o.y = pk2(v[2] * sc, v[3] * sc); o.z = pk2(v[4] * sc, v[5] * sc); o.w = pk2(v[6] * sc, v[7] * sc);
                *((u32x4*)(P + (size_t)m * PW + col) + lane) = o;
            }
        }
    }
    bf16* POOL = (bf16*)(ap->ws + WS_POOL);
    for (int it = gt; it < M * 32; it += NGT) {
        const int m = it >> 5, ch = it & 31, pos = m & (SEQ - 1), g = ch >> 3, wnd = 2 << g;
        const int cnt = (pos + 1 < wnd) ? pos + 1 : wnd;
        u32x4 wl[16];
#pragma unroll
        for (int i = 0; i < 16; ++i) { wl[i] = (u32x4){0u, 0u, 0u, 0u}; if (i < cnt) wl[i] = *(const u32x4*)(P + (size_t)(m - i) * PW + ch * 8); }
        float s8[8];
#pragma unroll
        for (int j = 0; j < 8; ++j) s8[j] = 0.f;
#pragma unroll
        for (int i = 0; i < 16; ++i) { s8[0] += bflo(wl[i].x); s8[1] += bfhi(wl[i].x); s8[2] += bflo(wl[i].y); s8[3] += bfhi(wl[i].y); s8[4] += bflo(wl[i].z); s8[5] += bfhi(wl[i].z); s8[6] += bflo(wl[i].w); s8[7] += bfhi(wl[i].w); }
        const float inv = 1.0f / (float)cnt;
        const u32x4 w0 = wl[0];
        u32x4 o; o.x = pk2(s8[0] * inv - bflo(w0.x), s8[1] * inv - bfhi(w0.x)); o.y = pk2(s8[2] * inv - bflo(w0.y), s8[3] * inv - bfhi(w0.y));
        o.z = pk2(s8[4] * inv - bflo(w0.z), s8[5] * inv - bfhi(w0.z)); o.w = pk2(s8[6] * inv - bflo(w0.w), s8[7] * inv - bfhi(w0.w));
        *(u32x4*)(POOL + (size_t)m * 256 + ch * 8) = o;
    }
    if (blockIdx.x < 32) {
        const int bh = blockIdx.x, b = bh >> 2, h = bh & 3, lane = tid & 63, wave = tid >> 6;
        const float* lf = (const float*)(ap->ws + WS_LOGF) + (size_t)b * SEQ * 4 + h;
        float* cum = (float*)(ap->ws + WS_CUM) + (size_t)bh * SEQ;
        LAS float* wsum = (LAS float*)(lds + LDS_MISC + 64);
        float loc[16]; float run = 0.f;
#pragma unroll
        for (int i = 0; i < 16; ++i) { run += lf[(size_t)(tid * 16 + i) * 4]; loc[i] = run; }
        float inc = run;
#pragma unroll
        for (int o = 1; o < 64; o <<= 1) { const float t = __shfl_up(inc, o); if (lane >= o) inc += t; }
        if (lane == 63) wsum[wave] = inc;
        __syncthreads();
        float off = inc - run;
        for (int w2 = 0; w2 < wave; ++w2) off += wsum[w2];
#pragma unroll
        for (int i = 0; i < 16; ++i) cum[tid * 16 + i] = loc[i] + off;
        __syncthreads();
    }
}

constexpr int A_KS = 0, A_KS_SZ = 64 * 144, A_VT = 2 * A_KS_SZ, A_VT_SZ = 64 * 320, A_BIAS = A_VT + 2 * A_VT_SZ, A_FLAG = A_BIAS + 512, A_END = A_FLAG + 64;
static_assert(A_END <= LDS_MISC, "attention LDS");
__device__ __forceinline__ int crow(int r, int hi) { return (r & 3) + 8 * (r >> 2) + 4 * hi; }

template <int TYPE, int DV>
__device__ __forceinline__ void attn_pass(LAS unsigned char* lds, const bf16* Qrow, const bf16* Kb, const bf16* Vb, const float* cum, int q0, int NT, f32x16 (&o)[DV / 32], float& l_out, const float smax = 0.f) {
    const int tid = tid_l(), lane = tid & 63, r32 = lane & 31, hi = lane >> 5, wid = __builtin_amdgcn_readfirstlane(tid >> 6);
    const int qw = q0 + 32 * wid, qrow = qw + r32, kdiag = qw >> 6;
    bf16x8 qf[4];
#pragma unroll
    for (int d0 = 0; d0 < 4; ++d0) qf[d0] = *(const bf16x8*)(Qrow + d0 * 16 + hi * 8);
    const int skey = tid >> 3, sch = tid & 7;
    constexpr int VPITCH = (DV == 64) ? 192 : 320;
    const int vtoff = (4 * hi + ((lane >> 2) & 3)) * VPITCH + (((lane >> 4) & 1) * 16 + (lane & 3) * 4) * 2;
    const bf16* ksrc = Kb + (size_t)skey * PW + sch * 8;
    const bf16* vsrc = Vb + (size_t)skey * PW + sch * 8;
    const float cref = (TYPE == 2) ? cum[q0] : 0.f;
    u32x4 kreg, vreg[DV / 64]; float breg = 0.f;
    const int t_first = (TYPE != 0) ? NT - 1 : 0, step = (TYPE != 0) ? -1 : 1;
#define A_LOAD(kt) do { kreg = *(const u32x4*)(ksrc + (size_t)(kt) * 64 * PW); \
        _Pragma("unroll") for (int i_ = 0; i_ < DV / 64; ++i_) vreg[i_] = *(const u32x4*)(vsrc + (size_t)(kt) * 64 * PW + i_ * 64); \
        if (TYPE == 2 && tid < 64) breg = cum[(kt) * 64 + tid]; } while (0)
#define A_STORE(buf) do { *(LAS u32x4*)(lds + A_KS + (buf) * A_KS_SZ + skey * 144 + sch * 16) = kreg; \
        _Pragma("unroll") for (int i_ = 0; i_ < DV / 64; ++i_) *(LAS u32x4*)(lds + A_VT + (buf) * A_VT_SZ + skey * VPITCH + i_ * 128 + sch * 16) = vreg[i_]; \
        if (TYPE == 2 && tid < 64) *(LAS float*)(lds + A_BIAS + (buf) * 256 + tid * 4) = (cref - breg) * LOG2E; } while (0)
    A_LOAD(t_first); A_STORE(0); if (NT > 1) A_LOAD(t_first + step); __syncthreads();
    float m_run = 0.f, l_run = 0.f, R = 0.f;
    f32x16 negm;
#pragma unroll
    for (int r = 0; r < 16; ++r) negm[r] = 0.f;
    bool nomax = (TYPE == 0) && (smax <= 60.0f);
    bool fresh = !nomax;
    for (int it = 0; it < NT; ++it) {
        const int kt = t_first + step * it, buf = it & 1; const bool more = it + 1 < NT;
        if (more) { A_STORE(buf ^ 1); if (it + 2 < NT) A_LOAD(kt + 2 * step); }
        float bnext = 0.f;
        if (TYPE == 2 && kt > 0) bnext = (cref - cum[kt * 64 - 1]) * LOG2E;
        int wdone = 0;
        if (kt <= kdiag) {
            const LAS unsigned char* kp = lds + A_KS + buf * A_KS_SZ + r32 * 144 + hi * 16;
            const LAS unsigned char* vp = lds + A_VT + buf * A_VT_SZ + vtoff;
            bf16x8 kf[8];
#pragma unroll
            for (int d0 = 0; d0 < 4; ++d0) { kf[2 * d0] = *(const LAS bf16x8*)(kp + d0 * 32); kf[2 * d0 + 1] = *(const LAS bf16x8*)(kp + 32 * 144 + d0 * 32); }
            __builtin_amdgcn_sched_barrier(0);
            f32x16 s0, s1;
            if (TYPE == 1 || nomax) {
                const f32x16 zz = {0.f, 0.f, 0.f, 0.f, 0.f, 0.f, 0.f, 0.f, 0.f, 0.f, 0.f, 0.f, 0.f, 0.f, 0.f, 0.f};
                s0 = __builtin_amdgcn_mfma_f32_32x32x16_bf16(kf[0], qf[0], zz, 0, 0, 0);
                s1 = __builtin_amdgcn_mfma_f32_32x32x16_bf16(kf[1], qf[0], zz, 0, 0, 0);
            } else {
                s0 = __builtin_amdgcn_mfma_f32_32x32x16_bf16(kf[0], qf[0], negm, 0, 0, 0);
                s1 = __builtin_amdgcn_mfma_f32_32x32x16_bf16(kf[1], qf[0], negm, 0, 0, 0);
            }
#pragma unroll
            for (int d0 = 1; d0 < 4; ++d0) {
                s0 = __builtin_amdgcn_mfma_f32_32x32x16_bf16(kf[2 * d0], qf[d0], s0, 0, 0, 0);
                s1 = __builtin_amdgcn_mfma_f32_32x32x16_bf16(kf[2 * d0 + 1], qf[d0], s1, 0, 0, 0);
            }
            __builtin_amdgcn_sched_barrier(0);
            s16x4 vf[2][4][2];
#pragma unroll
            for (int dt = 0; dt < 2; ++dt)
#pragma unroll
                for (int c = 0; c < 4; ++c) {
                    vf[dt][c][0] = __builtin_amdgcn_ds_read_tr16_b64_v4i16((LAS s16x4*)(vp + (16 * c) * VPITCH + dt * 64));
                    vf[dt][c][1] = __builtin_amdgcn_ds_read_tr16_b64_v4i16((LAS s16x4*)(vp + (16 * c + 8) * VPITCH + dt * 64)); }
            __builtin_amdgcn_sched_barrier(0);
            if (TYPE == 2) {
                const LAS float* bp = (const LAS float*)(lds + A_BIAS + buf * 256) + 4 * hi;
#pragma unroll
                for (int g = 0; g < 4; ++g) { const f32x4 b0 = *(const LAS f32x4*)(bp + 8 * g), b1 = *(const LAS f32x4*)(bp + 32 + 8 * g);
#pragma unroll
                    for (int j = 0; j < 4; ++j) { s0[4 * g + j] += b0[j]; s1[4 * g + j] += b1[j]; } }
            }
            if (kt == kdiag) {
                const int kb = kt * 64 + 4 * hi, lim = (TYPE == 1) ? qrow - 1 : qrow;
#pragma unroll
                for (int r = 0; r < 16; ++r) { const int kv = kb + (r & 3) + 8 * (r >> 2); if (kv > lim) s0[r] = -INFINITY; if (kv + 32 > lim) s1[r] = -INFINITY; }
            }
            if (TYPE == 1) {
                f32x16 L0, L1;
#pragma unroll
                for (int r = 0; r < 16; ++r) {
                    const float z0 = s0[r], z1 = s1[r];
                    L0[r] = -(fmaxf(z0, 0.f) + __builtin_amdgcn_logf(1.0f + __builtin_amdgcn_exp2f(-fabsf(z0))));
                    L1[r] = -(fmaxf(z1, 0.f) + __builtin_amdgcn_logf(1.0f + __builtin_amdgcn_exp2f(-fabsf(z1))));
                }
#define SB_G0(a) ((L0[4 * (a)] + L0[4 * (a) + 1]) + (L0[4 * (a) + 2] + L0[4 * (a) + 3]))
#define SB_G1(a) ((L1[4 * (a)] + L1[4 * (a) + 1]) + (L1[4 * (a) + 2] + L1[4 * (a) + 3]))
                const float T7 = SB_G1(3), T6 = SB_G1(2) + T7, T5 = SB_G1(1) + T6, T4 = SB_G1(0) + T5, T3 = SB_G0(3) + T4, T2 = SB_G0(2) + T3, T1 = SB_G0(1) + T2, T0 = SB_G0(0) + T1;
                const float P0 = partner32(T0), P1 = partner32(T1), P2 = partner32(T2), P3 = partner32(T3), P4 = partner32(T4), P5 = partner32(T5), P6 = partner32(T6), P7 = partner32(T7);
#define SB_APPLY(S, L, q, TN, PA, PB) do { float sf = R + (TN) + (hi ? (PB) : (PA)); \
                    S[(q) + 3] = __builtin_amdgcn_exp2f(S[(q) + 3] + L[(q) + 3] + sf); sf += L[(q) + 3]; \
                    S[(q) + 2] = __builtin_amdgcn_exp2f(S[(q) + 2] + L[(q) + 2] + sf); sf += L[(q) + 2]; \
                    S[(q) + 1] = __builtin_amdgcn_exp2f(S[(q) + 1] + L[(q) + 1] + sf); sf += L[(q) + 1]; \
                    S[(q)] = __builtin_amdgcn_exp2f(S[(q)] + L[(q)] + sf); } while (0)
                SB_APPLY(s0, L0, 0, T1, P0, P1); SB_APPLY(s0, L0, 4, T2, P1, P2); SB_APPLY(s0, L0, 8, T3, P2, P3); SB_APPLY(s0, L0, 12, T4, P3, P4);
                SB_APPLY(s1, L1, 0, T5, P4, P5); SB_APPLY(s1, L1, 4, T6, P5, P6); SB_APPLY(s1, L1, 8, T7, P6, P7); SB_APPLY(s1, L1, 12, 0.f, P7, 0.f);
#undef SB_G0
#undef SB_G1
#undef SB_APPLY
                R += T0 + P0;
            } else {
                float mx = 0.f;
                if (TYPE != 0 || !nomax) {
                asm volatile("s_nop 15\n\ts_nop 7" : "+v"(s0), "+v"(s1));
                float ma = max3f(s0[0], s0[1], s1[0]), mb = max3f(s0[2], s0[3], s1[1]);
                ma = max3f(ma, s1[2], s1[3]);
#pragma unroll
                for (int r = 4; r < 16; r += 4) { ma = max3f(ma, s0[r], s0[r + 1]); mb = max3f(mb, s0[r + 2], s0[r + 3]); ma = max3f(ma, s1[r], s1[r + 1]); mb = max3f(mb, s1[r + 2], s1[r + 3]); }
                mx = fmaxf(ma, mb);
                mx = fmaxf(mx, partner32(mx));
                }
                if (fresh || __any(mx > 16.0f)) {
                    const float dl = fresh ? mx : fmaxf(mx, 0.f);
                    m_run += dl;
#pragma unroll
                    for (int r = 0; r < 16; ++r) { s0[r] -= dl; s1[r] -= dl; negm[r] = -m_run; }
                    if (!fresh) {
                        const float alpha = __builtin_amdgcn_exp2f(-dl);
                        l_run *= alpha;
#pragma unroll
                        for (int dt = 0; dt < DV / 32; ++dt)
#pragma unroll
                            for (int r = 0; r < 16; ++r) o[dt][r] *= alpha;
                    }
                    fresh = false;
                    if (TYPE == 0) nomax = __all(m_run >= smax - 8.0f) != 0;
                }
#pragma unroll
                for (int r = 0; r < 16; ++r) { s0[r] = __builtin_amdgcn_exp2f(s0[r]); s1[r] = __builtin_amdgcn_exp2f(s1[r]); }
                asm volatile("s_nop 1" : "+v"(s0), "+v"(s1));
                float pa = s0[0], pb = s1[0], pc = s0[1], pd = s1[1];
#pragma unroll
                for (int r = 2; r < 16; r += 2) { pa = fadd_v(pa, s0[r]); pb = fadd_v(pb, s1[r]); pc = fadd_v(pc, s0[r + 1]); pd = fadd_v(pd, s1[r + 1]); }
                l_run += (pa + pb) + (pc + pd);
            }
            __builtin_amdgcn_sched_barrier(0);
            u32x4 pw[4];
            pw[0] = (u32x4){pk2(s0[0], s0[1]), pk2(s0[2], s0[3]), pk2(s0[4], s0[5]), pk2(s0[6], s0[7])};
            pw[1] = (u32x4){pk2(s0[8], s0[9]), pk2(s0[10], s0[11]), pk2(s0[12], s0[13]), pk2(s0[14], s0[15])};
            pw[2] = (u32x4){pk2(s1[0], s1[1]), pk2(s1[2], s1[3]), pk2(s1[4], s1[5]), pk2(s1[6], s1[7])};
            pw[3] = (u32x4){pk2(s1[8], s1[9]), pk2(s1[10], s1[11]), pk2(s1[12], s1[13]), pk2(s1[14], s1[15])};
#pragma unroll
            for (int dt = 0; dt < 2; ++dt)
#pragma unroll
                for (int c = 0; c < 4; ++c) {
                    const s16x4 lo = vf[dt][c][0], h2 = vf[dt][c][1];
                    const bf16x8 va = {lo[0], lo[1], lo[2], lo[3], h2[0], h2[1], h2[2], h2[3]};
                    o[dt] = __builtin_amdgcn_mfma_f32_32x32x16_bf16(va, __builtin_bit_cast(bf16x8, pw[c]), o[dt], 0, 0, 0);
                }
#pragma unroll
            for (int dt = 2; dt < DV / 32; ++dt)
#pragma unroll
                for (int c = 0; c < 4; ++c) {
                    const s16x4 lo = __builtin_amdgcn_ds_read_tr16_b64_v4i16((LAS s16x4*)(vp + (16 * c) * VPITCH + dt * 64));
                    const s16x4 h2 = __builtin_amdgcn_ds_read_tr16_b64_v4i16((LAS s16x4*)(vp + (16 * c + 8) * VPITCH + dt * 64));
                    const bf16x8 va = {lo[0], lo[1], lo[2], lo[3], h2[0], h2[1], h2[2], h2[3]};
                    o[dt] = __builtin_amdgcn_mfma_f32_32x32x16_bf16(va, __builtin_bit_cast(bf16x8, pw[c]), o[dt], 0, 0, 0);
                }
            if (TYPE == 1) wdone = __all(R < -160.0f) ? 1 : 0;
            if (TYPE == 2) wdone = (kt == 0 || __all(smax + bnext - m_run < -160.0f)) ? 1 : 0;
        }
        if (TYPE != 0 && lane == 0) *(LAS int*)(lds + A_FLAG + (buf * 8 + wid) * 4) = wdone;
        __syncthreads();
        if (TYPE != 0) {
            const u32x4 f0 = *(const LAS u32x4*)(lds + A_FLAG + buf * 32), f1 = *(const LAS u32x4*)(lds + A_FLAG + buf * 32 + 16);
            if ((f0.x & f0.y & f0.z & f0.w & f1.x & f1.y & f1.z & f1.w) != 0u) break;
        }
    }
    if (TYPE != 0) __syncthreads();
#undef A_LOAD
#undef A_STORE
    l_out = l_run + partner32(l_run);
}

template <int DV>
__device__ __forceinline__ void store_o(bf16* Orow, const f32x16 (&o)[DV / 32], int hi) {
#pragma unroll
    for (int dt = 0; dt < DV / 32; ++dt)
#pragma unroll
        for (int g = 0; g < 4; ++g) { u32x2 w; w.x = pk2(o[dt][4 * g], o[dt][4 * g + 1]); w.y = pk2(o[dt][4 * g + 2], o[dt][4 * g + 3]); *(u32x2*)(Orow + dt * 32 + 8 * g + 4 * hi) = w; }
}

__device__ __forceinline__ void attn_phase(int layer, LAS unsigned char* lds, const bool dry = false) {
    const ArgsP ap = get_args();
    const int tid = tid_l(), lane = tid & 63, r32 = lane & 31, hi = lane >> 5, wid = tid >> 6;
    bf16* P = (bf16*)(ap->ws + WS_P);
    unsigned* ctr = (unsigned*)(ap->ws + WS_CTL) + (layer + (dry ? 2 : 0)) * 8 * 64;
    const unsigned xcd0 = ((unsigned)__builtin_amdgcn_s_getreg((3 << 11) | 20) & 0xFu) & 7u;
    bf16* dummy = (bf16*)(ap->ws + WS_STASH + (size_t)blockIdx.x * STASH_BLK + 131072) + tid * 256;
    volatile LAS unsigned* ubox = (volatile LAS unsigned*)(lds + LDS_MISC);
    const float lambda_init = 0.8f - 0.6f * expf(-0.3f * (float)layer);
    float lam;
    {
        float d1 = 0.f, d2 = 0.f;
        for (int i = 0; i < 64; ++i) { d1 += ap->in[I_LQ1][layer * 64 + i] * ap->in[I_LK1][layer * 64 + i]; d2 += ap->in[I_LQ2][layer * 64 + i] * ap->in[I_LK2][layer * 64 + i]; }
        lam = expf(d1) - expf(d2) + lambda_init;
    }
    float fox_smax;
    {
        float gq = 0.f, gk = 0.f;
        for (int i = 0; i < 64; ++i) { gq = fmaxf(gq, fabsf(ap->in[I_FQN][layer * 64 + i])); gk = fmaxf(gk, fabsf(ap->in[I_FKN][layer * 64 + i])); }
        fox_smax = 64.0f * gq * gk * C2 * 1.02f;
    }
    float diff_smax;
    {
        float gq = 0.f, gk = 0.f;
        for (int i = 0; i < 64; ++i) { gq = fmaxf(gq, fabsf(ap->in[I_DQN][layer * 64 + i])); gk = fmaxf(gk, fabsf(ap->in[I_DKN][layer * 64 + i])); }
        diff_smax = 64.0f * gq * gk * C2 * 1.02f;
    }
    for (;;) {
        __syncthreads();
        if (tid == 0) {
            unsigned got = 0xffffffffu;
            for (unsigned a = 0; a < 8u; ++a) { const unsigned x = (xcd0 + a) & 7u;
                const unsigned j = __hip_atomic_fetch_add(ctr + x * 64, 1u, __ATOMIC_RELAXED, __HIP_MEMORY_SCOPE_AGENT);
                if (j < 384u) { got = x * 384u + j; break; } }
            ubox[0] = got;
        }
        __syncthreads();
        const unsigned u = ubox[0];
        if (u == 0xffffffffu) break;
        const int ux = (int)(u / 384u), uj = (int)(u % 384u), ut = uj >> 7, jj = uj & 127;
        const int type = ut == 0 ? 0 : (ut == 1 ? 2 : 1), bh = ux + 8 * (jj >> 5), qb = 31 - (jj & 31), b = bh >> 2, h = bh & 3;
        const int q0 = qb * 256, NT = 4 * qb + 4;
        const size_t rowbase = (size_t)b * SEQ;
        bf16* Pq = P + (rowbase + q0 + 32 * wid + r32) * PW;
        const bf16* Pk = P + rowbase * PW;
#ifndef TYM
#define TYM 7
#endif
        if ((TYM & 4) && type == 2) {
            f32x16 o[2];
#pragma unroll
            for (int r = 0; r < 16; ++r) { o[0][r] = 0.f; o[1][r] = 0.f; }
            float l;
            attn_pass<2, 64>(lds, Pq + C_FQ + h * 64, Pk + C_FK + h * 64, Pk + C_FV + h * 64, (const float*)(ap->ws + WS_CUM) + (size_t)bh * SEQ, q0, NT, o, l, fox_smax);
            const float inv = 1.0f / l;
#pragma unroll
            for (int r = 0; r < 16; ++r) { o[0][r] *= inv; o[1][r] *= inv; }
            store_o<64>(dry ? dummy : Pq + C_FQ + h * 64, o, hi);
        } else if ((TYM & 2) && type == 1) {
            f32x16 o[2];
#pragma unroll
            for (int r = 0; r < 16; ++r) { o[0][r] = 0.f; o[1][r] = 0.f; }
            float l;
            attn_pass<1, 64>(lds, Pq + C_SQ + h * 64, Pk + C_SK + h * 64, Pk + C_SV + h * 64, nullptr, q0, NT, o, l);
            store_o<64>(dry ? dummy : Pq + C_SQ + h * 64, o, hi);
        } else if (TYM & 1) {
            f32x16 o[4]; f32x4* o1s = (f32x4*)(ap->ws + WS_STASH + (size_t)blockIdx.x * STASH_BLK) + tid * 16;
#pragma unroll 1
            for (int mm = 0; mm < 2; ++mm) {
#pragma unroll
                for (int dt = 0; dt < 4; ++dt)
#pragma unroll
                    for (int r = 0; r < 16; ++r) o[dt][r] = 0.f;
                float l;
                attn_pass<0, 128>(lds, Pq + C_DQ + (h * 2 + mm) * 64, Pk + C_DK + (h * 2 + mm) * 64, Pk + C_DV + h * 128, nullptr, q0, NT, o, l, diff_smax);
                const float inv = 1.0f / l;
                if (mm == 0) {
#pragma unroll
                    for (int dt = 0; dt < 4; ++dt)
#pragma unroll
                        for (int g = 0; g < 4; ++g) o1s[dt * 4 + g] = (f32x4){o[dt][4 * g], o[dt][4 * g + 1], o[dt][4 * g + 2], o[dt][4 * g + 3]} * inv;
                } else {
                    float ss = 0.f;
#pragma unroll
                    for (int dt = 0; dt < 4; ++dt)
#pragma unroll
                        for (int g = 0; g < 4; ++g) { const f32x4 p1 = o1s[dt * 4 + g]; float q = 0.f;
#pragma unroll
                            for (int j = 0; j < 4; ++j) { const float c = p1[j] - lam * inv * o[dt][4 * g + j]; o[dt][4 * g + j] = c; q += c * c; }
                            ss += q; asm volatile("" : "+v"(ss) :: "memory"); }
                    ss += partner32(ss);
                    const float rn = (1.0f - lambda_init) / sqrtf(ss * (1.0f / 128.0f) + NORM_EPS);
                    const float* sg = ap->in[I_SUBLN] + layer * 128 + 4 * hi;
#pragma unroll
                    for (int dt = 0; dt < 4; ++dt)
#pragma unroll
                        for (int g = 0; g < 4; ++g) { const f32x4 gg = *(const f32x4*)(sg + dt * 32 + 8 * g);
#pragma unroll
                            for (int j = 0; j < 4; ++j) o[dt][4 * g + j] *= rn * gg[j];
                            if (g == 3) asm volatile("" ::: "memory"); }
                    store_o<128>(dry ? dummy : Pq + C_DQ + h * 128, o, hi);
                }
            }
        }
    }
}


#define XB_TMO      128
#define XB_XCNT(j)  (256  + 64 * (j))
#define XB_XSUB(j)  (1280 + 64 * (j))
#define XB_XGEN(j)  (2304 + 64 * (j))
#define XB_TOP      3328
#define XB_TOPGEN   3392
#define XCD_BAR_WORDS 3456
#define XB_SPIN_CAP (1u << 22)
__device__ __forceinline__ unsigned xb_ld(unsigned* p)              { return __hip_atomic_load(p, __ATOMIC_RELAXED, __HIP_MEMORY_SCOPE_AGENT); }
__device__ __forceinline__ unsigned xb_add(unsigned* p, unsigned v) { return __hip_atomic_fetch_add(p, v, __ATOMIC_RELAXED, __HIP_MEMORY_SCOPE_AGENT); }
__device__ __forceinline__ unsigned xb_xcc_id() { return (unsigned)__builtin_amdgcn_s_getreg((3 << 11) | 20) & 0xFu; }
#define XB_SPIN(cond, bar) do { unsigned _sp = 0; while (cond) { __builtin_amdgcn_s_sleep(1); \
    if ((++_sp & 255u) == 0u) { if (xb_ld(&(bar)[XB_TMO])) break; if (_sp > XB_SPIN_CAP) { atomicAdd(&(bar)[XB_TMO], 1u); break; } } } } while (0)
struct XcdBarrier { unsigned* bar; unsigned x; volatile LAS unsigned* st; };
__device__ __forceinline__ XcdBarrier xcd_barrier_post(unsigned* bar, volatile LAS unsigned* st) {
    XcdBarrier b; b.bar = bar; b.x = xb_xcc_id(); b.st = st;
    if (threadIdx.x == 0) (void)xb_add(&bar[XB_XCNT(b.x)], 1u);
    return b;
}
__device__ __forceinline__ void xcd_barrier_complete(unsigned* bar, unsigned x, unsigned& nloc, unsigned& nx) {
    const unsigned G = gridDim.x * gridDim.y * gridDim.z;
    unsigned sum, cnt, mine, sp = 0u;
    for (;;) {
        sum = 0u; cnt = 0u; mine = 0u;
#pragma unroll
        for (unsigned j = 0; j < 16; ++j) { const unsigned c = xb_ld(&bar[XB_XCNT(j)]); sum += c; cnt += (c > 0u) ? 1u : 0u; mine = (j == x) ? c : mine; }
        if (sum == G) break;
        __builtin_amdgcn_s_sleep(1);
        if ((++sp & 255u) == 0u) { if (xb_ld(&bar[XB_TMO])) break; if (sp > XB_SPIN_CAP) { atomicAdd(&bar[XB_TMO], 1u); break; } }
    }
    nloc = mine > 0u ? mine : 1u; nx = cnt > 0u ? cnt : 1u;
}
__device__ __forceinline__ void xcd_barrier(const XcdBarrier& b) {
    asm volatile("s_waitcnt vmcnt(0)" ::: "memory");
    __syncthreads();
    if (threadIdx.x == 0) {
        unsigned* bar = b.bar;
        __builtin_amdgcn_s_waitcnt(0);
        unsigned nloc = b.st[0], nx = b.st[1];
        if (nloc == 0u) { xcd_barrier_complete(bar, b.x, nloc, nx); b.st[0] = nloc; b.st[1] = nx; }
        const unsigned old = xb_add(&bar[XB_XSUB(b.x)], 1u);
        const unsigned gen = old / nloc;
        if (old + 1u == (gen + 1u) * nloc) {
            __builtin_amdgcn_fence(__ATOMIC_RELEASE, "agent");
            asm volatile("s_waitcnt vmcnt(0)" ::: "memory");
            const unsigned og = xb_add(&bar[XB_TOP], 1u);
            const unsigned tg = og / nx;
            if (og + 1u == (tg + 1u) * nx) xb_add(&bar[XB_TOPGEN], 1u);
            else XB_SPIN(xb_ld(&bar[XB_TOPGEN]) == tg, bar);
            __builtin_amdgcn_fence(__ATOMIC_ACQUIRE, "agent");
            xb_add(&bar[XB_XGEN(b.x)], 1u);
            asm volatile("s_waitcnt vmcnt(0)" ::: "memory");
        } else {
            XB_SPIN(xb_ld(&bar[XB_XGEN(b.x)]) == gen, bar);
            __builtin_amdgcn_fence(__ATOMIC_ACQUIRE, "agent");
            asm volatile("s_waitcnt vmcnt(0)" ::: "memory");
        }
    }
    __syncthreads();
}

#ifndef PH
#define PH 0xFFFF
#endif
__global__ void __launch_bounds__(512, 2) mega_fwd(Args a_unused) {
    extern __shared__ __attribute__((aligned(16))) unsigned char lds_raw[];
    LAS unsigned char* lds = (LAS unsigned char*)lds_raw;
    cg::grid_group grid = cg::this_grid();
    const int G = gridDim.x, bx = blockIdx.x;
    if (threadIdx.x < 8) ((volatile LAS unsigned*)(lds + LDS_MISC + 128))[threadIdx.x] = 0u;
    __syncthreads();
    const XcdBarrier xbar = xcd_barrier_post((unsigned*)(get_args()->ws + WS_CTL) + 4096, (volatile LAS unsigned*)(lds + LDS_MISC + 128));
#define GSYNC() xcd_barrier(xbar)

    if (PH & 1) prologue(lds);
#pragma unroll 1
    for (int layer = 0; layer < 2; ++layer) {
        if (PH & 2) { const ArgsP ap = get_args(); const float* xin = layer == 0 ? ap->in[I_X] : ap->out;
          norm_phase<true>(xin, ap->in[I_ANORM] + layer * DM, (bf16*)(ap->ws + WS_H), ap->in[I_WIN] + (size_t)layer * DM * DIN, ap->in[I_BFORGET] + layer * 4, (float*)(ap->ws + WS_LOGF)); }
        if (layer == 0) grid.sync(); else GSYNC();
        if (PH & 4) { const ArgsP ap = get_args(); unsigned char* ws = ap->ws; const unsigned char* wl = ws + WS_W + (size_t)layer * W_LAYER;
          pg8::SimpleSched S; S.A = (const char*)(ws + WS_H); S.B = (const char*)(wl + WO_IN); S.lda2 = 2048; S.ldb2 = 2048; S.nt = 16; S.ord.init(256, 13, G, bx);
          pg8::EpiStore E{(bf16*)(ws + WS_P), PW}; pg8::gemm_phase(lds, S, E); }
        GSYNC();
        if (PH & 8) e1_phase(layer, lds);
        GSYNC();
#ifdef DRY_ATTN
        attn_phase(layer, lds, true);
#endif
        if (PH & 16) attn_phase(layer, lds);
        GSYNC();
        if (PH & 32) { const ArgsP ap = get_args(); unsigned char* ws = ap->ws; const unsigned char* wl = ws + WS_W + (size_t)layer * W_LAYER;
          pg8::MergeSched S; S.H = (const char*)(ws + WS_H); S.P = (const char*)(ws + WS_P); S.POOL = (const char*)(ws + WS_POOL); S.wl = (const char*)wl;
          S.ord.init(256, 4, G, bx);
          pg8::EpiMerge E{ap->in[I_BGATE] + layer * 4 * DM, (u32x4*)(ws + WS_STASH + (size_t)bx * STASH_BLK), (bf16*)(ws + WS_MERGED)};
          pg8::gemm_phase(lds, S, E); }
        GSYNC();
        if (PH & 64) { const ArgsP ap = get_args(); unsigned char* ws = ap->ws; const unsigned char* wl = ws + WS_W + (size_t)layer * W_LAYER;
          pg8::SimpleSched S; S.A = (const char*)(ws + WS_MERGED); S.B = (const char*)(wl + WO_OUT); S.lda2 = 2048; S.ldb2 = 2048; S.nt = 16; S.ord.init(256, 4, G, bx);
          pg8::EpiResid E{layer == 0 ? ap->in[I_X] : ap->out, ap->out}; pg8::gemm_phase(lds, S, E); }
        GSYNC();
        if (PH & 128) { const ArgsP ap = get_args();
          norm_phase<false>(ap->out, ap->in[I_FNORM] + layer * DM, (bf16*)(ap->ws + WS_H), nullptr, nullptr, nullptr); }
        GSYNC();
        if (PH & 256) { const ArgsP ap = get_args(); unsigned char* ws = ap->ws; const unsigned char* wl = ws + WS_W + (size_t)layer * W_LAYER;
          pg8::SimpleSched S; S.A = (const char*)(ws + WS_H); S.B = (const char*)(wl + WO_UP); S.lda2 = 2048; S.ldb2 = 2048; S.nt = 16; S.ord.init(256, 22, G, bx);
          pg8::EpiSwiGLU E{(bf16*)(ws + WS_P)}; pg8::gemm_phase(lds, S, E); }
        GSYNC();
        if (PH & 512) { const ArgsP ap = get_args(); unsigned char* ws = ap->ws; const unsigned char* wl = ws + WS_W + (size_t)layer * W_LAYER;
          pg8::SimpleSched S; S.A = (const char*)(ws + WS_P); S.B = (const char*)(wl + WO_DN); S.lda2 = DFF * 2; S.ldb2 = DFF * 2; S.nt = DFF / 64; S.ord.init(256, 4, G, bx);
          pg8::EpiResid E{ap->out, ap->out}; pg8::gemm_phase(lds, S, E); }
        if (layer == 0) GSYNC();
    }
}

extern "C" void kernel_launch(void* const* d_in, const int* in_sizes, int n_in, void* d_out, int out_size, void* d_ws, size_t ws_size, hipStream_t stream) {
    static int grid = 0;
    if (grid == 0) {
        if (n_in != 21 || out_size != M * DM || ws_size < WS_END) { fprintf(stderr, "kernel_launch: unexpected shapes: n_in %d out %d ws %zu (need %zu)\n", n_in, out_size, ws_size, (size_t)WS_END); grid = -1; return; }
        int dev = 0, cus = 0, per = 0;
        (void)hipGetDevice(&dev); (void)hipDeviceGetAttribute(&cus, hipDeviceAttributeMultiprocessorCount, dev);
        (void)hipFuncSetAttribute((const void*)mega_fwd, hipFuncAttributeMaxDynamicSharedMemorySize, LDS_BYTES);
        (void)hipOccupancyMaxActiveBlocksPerMultiprocessor(&per, (const void*)mega_fwd, 512, LDS_BYTES);
        if (per < 1) fprintf(stderr, "kernel_launch: occupancy query says %d blocks/CU\n", per);
        (void)hipGetLastError();
        grid = cus;
    }
    if (grid < 0) return;
    (void)hipMemsetAsync(d_ws, 0, 65536, stream);
    Args a{};
    for (int i = 0; i < 21; ++i) a.in[i] = (const float*)d_in[i];
    a.out = (float*)d_out; a.ws = (unsigned char*)d_ws;
    void* args[] = {&a};
    hipError_t e = hipLaunchCooperativeKernel((const void*)mega_fwd, dim3(grid), dim3(512), args, LDS_BYTES, stream);
    if (e != hipSuccess) fprintf(stderr, "kernel_launch: cooperative launch failed: %s (grid %d)\n", hipGetErrorString(e), grid);
}
```

```cpp
#include <hip/hip_runtime.h>
#include <hip/hip_cooperative_groups.h>
#include <cstdio>
#include <cstdint>
namespace cg = cooperative_groups;

#define LAS __attribute__((address_space(3)))
typedef unsigned short bf16;
typedef short bf16x8 __attribute__((ext_vector_type(8)));
typedef float f32x4 __attribute__((ext_vector_type(4)));
typedef float f32x16 __attribute__((ext_vector_type(16)));
typedef unsigned u32x4 __attribute__((ext_vector_type(4)));
typedef unsigned u32x2 __attribute__((ext_vector_type(2)));
typedef short s16x4 __attribute__((ext_vector_type(4)));
typedef float f32x2_t __attribute__((ext_vector_type(2)));
typedef __bf16 bf16x2_t __attribute__((ext_vector_type(2)));

constexpr int M = 65536, DM = 1024, SEQ = 8192, PW = 3328, DFF = 2816, DIN = 7428, NWAVES = 8;
constexpr float NORM_EPS = 1e-6f, LOG2E = 1.4426950408889634f;
constexpr float C2 = 0.125f * 1.4426950408889634f;
constexpr int C_POOL = 0, C_DQ = 256, C_DK = 768, C_DV = 1280, C_SQ = 1792, C_SK = 2048, C_SV = 2304, C_FQ = 2560, C_FK = 2816, C_FV = 3072;
constexpr size_t MiB = 1u << 20;
constexpr size_t WS_CTL = 0, WS_ROPE = 1 * MiB, WS_LOGF = 3 * MiB, WS_CUM = 4 * MiB, WS_W = 8 * MiB, W_LAYER = 36 * MiB;
constexpr size_t WO_IN = 0, WO_G = 6815744, WO_BR0 = WO_G + 8 * MiB, WO_BR1 = WO_BR0 + 524288, WO_BR2 = WO_BR1 + 1048576, WO_BR3 = WO_BR2 + 524288,
                 WO_OUT = WO_BR3 + 524288, WO_UP = WO_OUT + 2 * MiB, WO_DN = WO_UP + 11 * MiB;
static_assert(WO_DN + (size_t)DM * DFF * 2 <= W_LAYER, "weights");
constexpr size_t WS_H = 80 * MiB, WS_P = 208 * MiB, WS_POOL = 624 * MiB, WS_MERGED = 656 * MiB, WS_STASH = 784 * MiB, WS_END = 912 * MiB;
constexpr size_t STASH_BLK = 524288;
constexpr int LDS_BYTES = 147456, LDS_MISC = 131072;

__device__ __forceinline__ unsigned pk2(float lo, float hi) { f32x2_t v = {lo, hi}; bf16x2_t b = __builtin_convertvector(v, bf16x2_t); return __builtin_bit_cast(unsigned, b); }
__device__ __forceinline__ float bflo(unsigned w) { return __uint_as_float(w << 16); }
__device__ __forceinline__ float bfhi(unsigned w) { return __uint_as_float(w & 0xffff0000u); }
__device__ __forceinline__ float wave_sum(float v) {
#pragma unroll
    for (int o = 1; o < 64; o <<= 1) v += __shfl_xor(v, o);
    return v;
}
__device__ __forceinline__ float max3f(float a, float b, float c) { float r; asm("v_max3_f32 %0, %1, %2, %3" : "=v"(r) : "v"(a), "v"(b), "v"(c)); return r; }
__device__ __forceinline__ float fadd_v(float a, float b) { float r; asm volatile("v_add_f32_e32 %0, %1, %2" : "=v"(r) : "v"(a), "v"(b)); return r; }
__device__ __forceinline__ float partner32(float v) {
    auto rr = __builtin_amdgcn_permlane32_swap(__float_as_uint(v), __float_as_uint(v), false, false);
    return (threadIdx.x & 32) ? __uint_as_float(rr[0]) : __uint_as_float(rr[1]);
}

__device__ __forceinline__ int tid_l() { int t = threadIdx.x; asm volatile("" : "+v"(t)); return t; }
namespace pg8 {
constexpr int BM = 256, BK = 64, HALF = 128, HTB = HALF * BK * 2, STAGE_BYTES = 8 * HTB, NXCD = 8, WGM = 8;
__host__ __device__ __forceinline__ int lds_byte(int r, int c) { const int st = (r >> 4) * 2 + (c >> 5), rr = r & 15, cc = c & 31, ob = rr * 64 + cc * 2; return st * 1024 + (ob ^ (((ob >> 9) & 1) << 5)); }
__host__ __device__ __forceinline__ void stage_rc(int b, int& R, int& C) { const int st = b / 1024, sb = b % 1024, swz = sb ^ (((sb >> 9) & 1) << 5); R = (st >> 1) * 16 + swz / 64; C = (st & 1) * 32 + (swz % 64) / 2; }
__host__ __device__ __forceinline__ int perm32(int rho) { const int n = rho >> 4, i = rho & 15; return 8 * (i >> 2) + 4 * n + (i & 3); }

struct Unit { const char* A; const char* B; int lda2, ldb2, nt, pm, pn, mode; };

struct TileOrder {
    int nM, nN, nwg, G, c;
    __device__ void init(int nM_, int nN_, int G_, int c_) { nM = nM_; nN = nN_; nwg = nM * nN; G = G_; c = c_; }
    __device__ bool get(int i, int& pm, int& pn) const {
        const long L = (long)i * G + c; if (L >= nwg) return false;
        int wgid = (int)L; { const int q = nwg / NXCD, r = nwg % NXCD, xcd = wgid % NXCD, off = wgid / NXCD; wgid = (xcd < r ? xcd * (q + 1) : r * (q + 1) + (xcd - r) * q) + off; }
        const int nig = WGM * nN, gid = wgid / nig, fm = gid * WGM, gsz = (nM - fm) < WGM ? (nM - fm) : WGM;
        pm = fm + ((wgid % nig) % gsz); pn = (wgid % nig) / gsz; return true;
    }
};

template <class Epi, class Sched>
__device__ __forceinline__ void gemm_phase(LAS unsigned char* lds, const Sched& S, const Epi& E) {
    const int tid = tid_l(), wid = __builtin_amdgcn_readfirstlane(tid >> 6), lane = tid & 63, wr = wid >> 2, wc = wid & 3, fr = lane & 15, fq = lane >> 4;
    unsigned rA[2], rB[2], cc2[2];
#pragma unroll
    for (int i = 0; i < 2; ++i) { int R, C; stage_rc(tid * 16 + i * 8192, R, C); rA[i] = (unsigned)R; rB[i] = (unsigned)((R & ~31) + perm32(R & 31)); cc2[i] = (unsigned)C * 2u; }
    const unsigned ldsw = (unsigned)wid * 1024u;
    const int aoff = lds_byte(wr * 64 + fr, fq * 8), boff = lds_byte(wc * 32 + fr, fq * 8);
#define PG8_SA(b, h) (((b) * 2 + (h)) * HTB)
#define PG8_SB(b, h) ((4 + (b) * 2 + (h)) * HTB)
#define PG8_STAGE(bufoff, gbase, rr, pitch) do { _Pragma("unroll") for (int _i = 0; _i < 2; ++_i) \
        __builtin_amdgcn_global_load_lds((const unsigned*)((const char*)(gbase) + (size_t)((rr)[_i] * (unsigned)(pitch) + cc2[_i])), (LAS unsigned*)(lds + (bufoff) + ldsw + _i * 8192), 16, 0, 0); } while (0)
#define PG8_LDA(dst, b, h) do { _Pragma("unroll") for (int m = 0; m < 4; ++m) _Pragma("unroll") for (int k = 0; k < 2; ++k) dst[m][k] = *(const LAS bf16x8*)(lds + PG8_SA(b, h) + aoff + m * 2048 + k * 1024); } while (0)
#define PG8_LDB(dst, b, h) do { _Pragma("unroll") for (int n = 0; n < 2; ++n) _Pragma("unroll") for (int k = 0; k < 2; ++k) dst[n][k] = *(const LAS bf16x8*)(lds + PG8_SB(b, h) + boff + n * 2048 + k * 1024); } while (0)
#define PG8_MMA(ai, bj, At, Bt) do { __builtin_amdgcn_s_setprio(1); _Pragma("unroll") for (int m = 0; m < 4; ++m) _Pragma("unroll") for (int n = 0; n < 2; ++n) _Pragma("unroll") for (int k = 0; k < 2; ++k) \
        acc[ai][bj][m][n] = __builtin_amdgcn_mfma_f32_16x16x32_bf16(Bt[n][k], At[m][k], acc[ai][bj][m][n], 0, 0, 0); __builtin_amdgcn_s_setprio(0); } while (0)
#define PG8_WAIT_V(n) asm volatile("s_waitcnt vmcnt(" #n ")" ::: "memory")
#define PG8_WAIT_L(n) asm volatile("s_waitcnt lgkmcnt(" #n ")" ::: "memory")
#define PG8_BAR __builtin_amdgcn_s_barrier()
#define PG8_SCHED __builtin_amdgcn_sched_barrier(0)
    Unit cur, nxt; int ui = 0;
    if (!S.next(0, cur)) return;
    f32x4 acc[2][2][4][2];
#pragma unroll
    for (int a = 0; a < 2; ++a)
#pragma unroll
        for (int b = 0; b < 2; ++b)
#pragma unroll
            for (int m = 0; m < 4; ++m)
#pragma unroll
                for (int n = 0; n < 2; ++n) acc[a][b][m][n] = (f32x4){0.f, 0.f, 0.f, 0.f};
    bf16x8 At[4][2], B0[2][2], B1[2][2];
    {
        const char* cA = cur.A; const char* cB = cur.B; const int pa = cur.lda2, pb = cur.ldb2;
        PG8_STAGE(PG8_SB(0, 0), cB, rB, pb); PG8_STAGE(PG8_SB(0, 1), cB + (size_t)HALF * pb, rB, pb); PG8_STAGE(PG8_SA(0, 0), cA, rA, pa); PG8_STAGE(PG8_SA(0, 1), cA + (size_t)HALF * pa, rA, pa);
        if (wr == 1) PG8_BAR;
        PG8_WAIT_V(2); PG8_BAR;
        PG8_STAGE(PG8_SB(1, 0), cB + 128, rB, pb); PG8_STAGE(PG8_SA(1, 0), cA + 128, rA, pa); PG8_STAGE(PG8_SB(1, 1), cB + (size_t)HALF * pb + 128, rB, pb);
        PG8_WAIT_V(6); PG8_BAR;
    }
    for (;;) {
        const bool has_next = S.next(ui + 1, nxt);
        if (!has_next) nxt = cur;
        const char* cA = cur.A; const char* cB = cur.B; const int cpa = cur.lda2, cpb = cur.ldb2, nt = cur.nt;
        for (int t = 0; t < nt; t += 2) {
            const bool last = (t == nt - 2);
            const char* a1 = cA + (size_t)(t + 1) * 128;
            const char* a2 = last ? nxt.A : cA + (size_t)(t + 2) * 128; const char* b2 = last ? nxt.B : cB + (size_t)(t + 2) * 128;
            const int pa2 = last ? nxt.lda2 : cpa, pb2 = last ? nxt.ldb2 : cpb;
            const char* a3 = a2 + 128; const char* b3 = b2 + 128;
            PG8_LDB(B0, 0, 0); PG8_LDB(B1, 0, 1); PG8_SCHED; PG8_LDA(At, 0, 0); PG8_STAGE(PG8_SA(1, 1), a1 + (size_t)HALF * cpa, rA, cpa);
            PG8_WAIT_V(8); PG8_WAIT_L(0); PG8_BAR; PG8_MMA(0, 0, At, B0); PG8_MMA(0, 1, At, B1); PG8_BAR; PG8_SCHED;
            PG8_LDA(At, 0, 1); PG8_STAGE(PG8_SB(0, 0), b2, rB, pb2); PG8_STAGE(PG8_SB(0, 1), b2 + (size_t)HALF * pb2, rB, pb2); PG8_STAGE(PG8_SA(0, 0), a2, rA, pa2);
            PG8_WAIT_V(8); PG8_WAIT_L(0); PG8_BAR; PG8_MMA(1, 0, At, B0); PG8_MMA(1, 1, At, B1); PG8_BAR; PG8_SCHED;
            PG8_LDB(B0, 1, 0); PG8_LDB(B1, 1, 1); PG8_SCHED; PG8_LDA(At, 1, 0); PG8_STAGE(PG8_SA(0, 1), a2 + (size_t)HALF * pa2, rA, pa2);
            PG8_WAIT_V(8); PG8_WAIT_L(0); PG8_BAR; PG8_MMA(0, 0, At, B0); PG8_MMA(0, 1, At, B1); PG8_BAR; PG8_SCHED;
            PG8_LDA(At, 1, 1); PG8_STAGE(PG8_SB(1, 0), b3, rB, pb2); PG8_STAGE(PG8_SB(1, 1), b3 + (size_t)HALF * pb2, rB, pb2); PG8_STAGE(PG8_SA(1, 0), a3, rA, pa2);
            PG8_WAIT_V(8); PG8_WAIT_L(0); PG8_BAR; PG8_MMA(1, 0, At, B0); PG8_MMA(1, 1, At, B1); PG8_BAR; PG8_SCHED;
        }
        if (wr == 0) PG8_BAR;
        E(acc, cur, wr, wc, fr, fq);
        if (!has_next) break;
        if (!Epi::SELF_ZERO) {
#pragma unroll
        for (int a = 0; a < 2; ++a)
#pragma unroll
            for (int b = 0; b < 2; ++b)
#pragma unroll
                for (int m = 0; m < 4; ++m)
#pragma unroll
                    for (int n = 0; n < 2; ++n) acc[a][b][m][n] = (f32x4){0.f, 0.f, 0.f, 0.f};
        }
        cur = nxt; ++ui;
        if (wr == 1) PG8_BAR;
    }
    PG8_WAIT_V(0);
    PG8_BAR;
#undef PG8_SA
#undef PG8_SB
#undef PG8_STAGE
#undef PG8_LDA
#undef PG8_LDB
#undef PG8_MMA
#undef PG8_WAIT_V
#undef PG8_WAIT_L
#undef PG8_BAR
#undef PG8_SCHED
}

struct SimpleSched {
    const char* A; const char* B; int lda2, ldb2, nt; TileOrder ord;
    __device__ __forceinline__ bool next(int i, Unit& u) const {
        int pm, pn; if (!ord.get(i, pm, pn)) return false;
        u.A = A + (size_t)pm * 256 * lda2; u.B = B + (size_t)pn * 256 * ldb2; u.lda2 = lda2; u.ldb2 = ldb2; u.nt = nt; u.pm = pm; u.pn = pn; u.mode = 0; return true;
    }
};
struct MergeSched {
    const char* H; const char* P; const char* POOL; const char* wl; TileOrder ord;
    __device__ __forceinline__ bool next(int i, Unit& u) const {
        int pm, pn; if (!ord.get(i >> 3, pm, pn)) return false;
        const int s = i & 7, n = s & 3;
        u.pm = pm; u.pn = pn; u.mode = s;
        if (s < 4) { u.A = H + (size_t)pm * 256 * 2048; u.lda2 = 2048; u.B = wl + WO_G + (size_t)(n * 1024 + pn * 256) * 2048; u.ldb2 = 2048; u.nt = 16; }
        else if (n == 0) { u.A = POOL + (size_t)pm * 256 * 512; u.lda2 = 512; u.B = wl + WO_BR0 + (size_t)pn * 256 * 512; u.ldb2 = 512; u.nt = 4; }
        else {
            const int col = n == 1 ? C_DQ : (n == 2 ? C_SQ : C_FQ), K = n == 1 ? 512 : 256;
            const char* wb = wl + (n == 1 ? WO_BR1 : (n == 2 ? WO_BR2 : WO_BR3));
            u.A = P + (size_t)pm * 256 * (PW * 2) + col * 2; u.lda2 = PW * 2; u.B = wb + (size_t)pn * 256 * (K * 2); u.ldb2 = K * 2; u.nt = K / 64;
        }
        return true;
    }
};

struct EpiStore {
    static constexpr bool SELF_ZERO = false;
    bf16* O; int ldc;
    __device__ __forceinline__ bool operator()(f32x4 (&acc)[2][2][4][2], const Unit& u, int wr, int wc, int fr, int fq) const {
        const int row0 = u.pm * BM + wr * 64 + fr, col0 = u.pn * BM + wc * 32 + 8 * fq;
#pragma unroll
        for (int ai = 0; ai < 2; ++ai)
#pragma unroll
            for (int m = 0; m < 4; ++m) { bf16* rowp = O + (size_t)(row0 + ai * HALF + m * 16) * ldc + col0;
#pragma unroll
                for (int bj = 0; bj < 2; ++bj) { const f32x4 v0 = acc[ai][bj][m][0], v1 = acc[ai][bj][m][1];
                    u32x4 w; w.x = pk2(v0[0], v0[1]); w.y = pk2(v0[2], v0[3]); w.z = pk2(v1[0], v1[1]); w.w = pk2(v1[2], v1[3]);
                    *(u32x4*)(rowp + bj * HALF) = w; } }
        return false;
    }
};
struct EpiResid {
    static constexpr bool SELF_ZERO = false;
    const float* base; float* out;
    __device__ __forceinline__ bool operator()(f32x4 (&acc)[2][2][4][2], const Unit& u, int wr, int wc, int fr, int fq) const {
        const int row0 = u.pm * BM + wr * 64 + fr, col0 = u.pn * BM + wc * 32 + 8 * fq;
#pragma unroll
        for (int ai = 0; ai < 2; ++ai)
#pragma unroll
            for (int m = 0; m < 4; ++m) { const size_t off = (size_t)(row0 + ai * HALF + m * 16) * DM + col0;
#pragma unroll
                for (int bj = 0; bj < 2; ++bj)
#pragma unroll
                    for (int n = 0; n < 2; ++n) { const f32x4 b = *(const f32x4*)(base + off + bj * HALF + 4 * n); *(f32x4*)(out + off + bj * HALF + 4 * n) = b + acc[ai][bj][m][n]; } }
        return false;
    }
};
struct EpiSwiGLU {
    static constexpr bool SELF_ZERO = false;
    bf16* Hf;
    __device__ __forceinline__ bool operator()(f32x4 (&acc)[2][2][4][2], const Unit& u, int wr, int wc, int fr, int fq) const {
        const int row0 = u.pm * BM + wr * 64 + fr, col0 = u.pn * HALF + wc * 32 + 8 * fq;
#pragma unroll
        for (int ai = 0; ai < 2; ++ai)
#pragma unroll
            for (int m = 0; m < 4; ++m) { unsigned w[4];
#pragma unroll
                for (int n = 0; n < 2; ++n) { const f32x4 g = acc[ai][0][m][n], up = acc[ai][1][m][n]; float r[4];
#pragma unroll
                    for (int j = 0; j < 4; ++j) r[j] = g[j] * up[j] * __builtin_amdgcn_rcpf(1.0f + __builtin_amdgcn_exp2f(-g[j] * LOG2E));
                    w[2 * n] = pk2(r[0], r[1]); w[2 * n + 1] = pk2(r[2], r[3]); }
                *(u32x4*)(Hf + (size_t)(row0 + ai * HALF + m * 16) * DFF + col0) = (u32x4){w[0], w[1], w[2], w[3]}; }
        return false;
    }
};
struct EpiMerge {
    static constexpr bool SELF_ZERO = true;
    const float* b_gate; u32x4* gst; bf16* merged;
    __device__ __forceinline__ bool operator()(f32x4 (&acc)[2][2][4][2], const Unit& u, int wr, int wc, int fr, int fq) const {
        const int tid = tid_l(), n_br = u.mode & 3;
        const bool gate = u.mode < 4, last = u.mode == 7;
        const float keepf = (!gate && !last) ? 1.0f : 0.0f;
        const int row0 = u.pm * BM + wr * 64 + fr, col0 = u.pn * BM + wc * 32 + 8 * fq;
        f32x4 bv[2][2];
#pragma unroll
        for (int bj = 0; bj < 2; ++bj)
#pragma unroll
            for (int n = 0; n < 2; ++n) bv[bj][n] = gate ? *(const f32x4*)(b_gate + n_br * DM + col0 + bj * HALF + 4 * n) : (f32x4){0.f, 0.f, 0.f, 0.f};
        u32x4* gp = gst + n_br * 8192 + tid;
#pragma unroll
        for (int ai = 0; ai < 2; ++ai)
#pragma unroll
            for (int m = 0; m < 4; ++m)
#pragma unroll
                for (int bj = 0; bj < 2; ++bj) {
                    f32x4 s0 = {1.f, 1.f, 1.f, 1.f}, s1 = {1.f, 1.f, 1.f, 1.f};
                    if (gate) { unsigned w[4];
#pragma unroll
                        for (int n = 0; n < 2; ++n) { const f32x4 v = acc[ai][bj][m][n] + bv[bj][n]; float r[4];
#pragma unroll
                            for (int j = 0; j < 4; ++j) r[j] = fmaxf(__builtin_amdgcn_rcpf(1.0f + __builtin_amdgcn_exp2f(-v[j] * LOG2E)), 1e-30f);
                            w[2 * n] = pk2(r[0], r[1]); w[2 * n + 1] = pk2(r[2], r[3]); }
                        *gp = (u32x4){w[0], w[1], w[2], w[3]};
                    } else {
                        const u32x4 g = *gp;
                        u32x4 h = {0x3f803f80u, 0x3f803f80u, 0x3f803f80u, 0x3f803f80u};
                        if (!last) { const u32x4* gq = gp + 8192; h = *gq; }
                        s0 = (f32x4){bflo(g.x) * __builtin_amdgcn_rcpf(bflo(h.x)), bfhi(g.x) * __builtin_amdgcn_rcpf(bfhi(h.x)), bflo(g.y) * __builtin_amdgcn_rcpf(bflo(h.y)), bfhi(g.y) * __builtin_amdgcn_rcpf(bfhi(h.y))};
                        s1 = (f32x4){bflo(g.z) * __builtin_amdgcn_rcpf(bflo(h.z)), bfhi(g.z) * __builtin_amdgcn_rcpf(bfhi(h.z)), bflo(g.w) * __builtin_amdgcn_rcpf(bflo(h.w)), bfhi(g.w) * __builtin_amdgcn_rcpf(bfhi(h.w))};
                    }
                    const f32x4 v0 = acc[ai][bj][m][0] * s0, v1 = acc[ai][bj][m][1] * s1;
                    if (last) { u32x4 w; w.x = pk2(v0[0], v0[1]); w.y = pk2(v0[2], v0[3]); w.z = pk2(v1[0], v1[1]); w.w = pk2(v1[2], v1[3]);
                                *(u32x4*)(merged + (size_t)(row0 + ai * HALF + m * 16) * DM + col0 + bj * HALF) = w; }
                    acc[ai][bj][m][0] = v0 * keepf; acc[ai][bj][m][1] = v1 * keepf;
                    gp += 512; asm volatile("" : "+v"(gp), "+v"(acc[ai][bj][m][0]), "+v"(acc[ai][bj][m][1]) :: "memory"); }
        return false;
    }
};
}

__device__ __forceinline__ void transpose_item(const float* W, int ldw, int k0, int c0, bf16* WT, int ldk, int r0, float scale, LAS float* scr, int lane) {
#pragma unroll
    for (int i = 0; i < 32; ++i) { const int kk = 2 * i + (lane >> 5); scr[kk * 33 + (lane & 31)] = W[(size_t)(k0 + kk) * ldw + c0 + (lane & 31)] * scale; }
    asm volatile("s_waitcnt lgkmcnt(0)" ::: "memory");
    const int c = lane & 7;
#pragma unroll
    for (int j = 0; j < 4; ++j) { const int n = (lane >> 3) + 8 * j; const LAS float* s = scr + (8 * c) * 33 + n;
        u32x4 o; o.x = pk2(s[0 * 33], s[1 * 33]); o.y = pk2(s[2 * 33], s[3 * 33]); o.z = pk2(s[4 * 33], s[5 * 33]); o.w = pk2(s[6 * 33], s[7 * 33]);
        *(u32x4*)(WT + (size_t)(r0 + n) * ldk + k0 + 8 * c) = o; }
    asm volatile("s_waitcnt lgkmcnt(0)" ::: "memory");
}

struct Args { const float* in[21]; float* out; unsigned char* ws; };
typedef const __attribute__((address_space(4))) Args* ArgsP;
__device__ __forceinline__ ArgsP get_args() { ArgsP p = (ArgsP)__builtin_amdgcn_kernarg_segment_ptr(); asm volatile("" : "+s"(p)); return p; }
enum { I_X = 0, I_ANORM, I_FNORM, I_WIN, I_BGATE, I_BFORGET, I_POOLW, I_POOLS, I_DQN, I_DKN, I_SUBLN, I_LQ1, I_LK1, I_LQ2, I_LK2, I_FQN, I_FKN, I_WBR, I_WOUT, I_WUP, I_WDN };

__device__ __forceinline__ void prologue(LAS unsigned char* lds) {
    const ArgsP ap = get_args();
    const int tid = tid_l(), lane = tid & 63, wave = __builtin_amdgcn_readfirstlane(tid >> 6), gw = blockIdx.x * NWAVES + wave, NGW = gridDim.x * NWAVES;
    LAS float* scr = (LAS float*)(lds + wave * 16384);
    constexpr int N_IN = 16 * 104, N_G = 16 * 128, N_B1 = 8 * 32, N_B2 = 4 * 32, N_B3 = 4 * 32, N_O = 16 * 32, N_UP = 16 * 176, N_DN = 44 * 32;
    constexpr int N_L = N_IN + N_G + N_B1 + N_B2 + N_B3 + N_O + N_UP + N_DN;
    for (int it = gw; it < 2 * N_L; it += NGW) {
        const int l = it / N_L; int r = it % N_L;
        unsigned char* wl = ap->ws + WS_W + (size_t)l * W_LAYER;
        const float* win = ap->in[I_WIN] + (size_t)l * DM * DIN;
        if (r < N_IN) { const int kb = r / 104, nb = r % 104, c0 = nb * 32; const float sc = (c0 >= C_SQ && c0 < C_SK) ? C2 : 1.0f;
            transpose_item(win, DIN, kb * 64, c0, (bf16*)(wl + WO_IN), DM, c0, sc, scr, lane); continue; } r -= N_IN;
        if (r < N_G) { const int kb = r / 128, nb = r % 128; transpose_item(win, DIN, kb * 64, 3332 + nb * 32, (bf16*)(wl + WO_G), DM, nb * 32, 1.0f, scr, lane); continue; } r -= N_G;
        const float* wbr = ap->in[I_WBR] + (size_t)l * 1280 * DM;
        if (r < N_B1) { const int kb = r / 32, nb = r % 32; transpose_item(wbr + (size_t)256 * DM, DM, kb * 64, nb * 32, (bf16*)(wl + WO_BR1), 512, nb * 32, 1.0f, scr, lane); continue; } r -= N_B1;
        if (r < N_B2) { const int kb = r / 32, nb = r % 32; transpose_item(wbr + (size_t)768 * DM, DM, kb * 64, nb * 32, (bf16*)(wl + WO_BR2), 256, nb * 32, 1.0f, scr, lane); continue; } r -= N_B2;
        if (r < N_B3) { const int kb = r / 32, nb = r % 32; transpose_item(wbr + (size_t)1024 * DM, DM, kb * 64, nb * 32, (bf16*)(wl + WO_BR3), 256, nb * 32, 1.0f, scr, lane); continue; } r -= N_B3;
        if (r < N_O) { const int kb = r / 32, nb = r % 32; transpose_item(ap->in[I_WOUT] + (size_t)l * DM * DM, DM, kb * 64, nb * 32, (bf16*)(wl + WO_OUT), DM, nb * 32, 1.0f, scr, lane); continue; } r -= N_O;
        if (r < N_UP) { const int kb = r / 176, nb = r % 176, c0 = nb * 32;
            const int isup = c0 >= DFF, f = isup ? c0 - DFF : c0, r0 = (f >> 7) * 256 + isup * 128 + (f & 127);
            transpose_item(ap->in[I_WUP] + (size_t)l * DM * 2 * DFF, 2 * DFF, kb * 64, c0, (bf16*)(wl + WO_UP), DM, r0, 1.0f, scr, lane); continue; } r -= N_UP;
        { const int kb = r / 32, nb = r % 32; transpose_item(ap->in[I_WDN] + (size_t)l * DFF * DM, DM, kb * 64, nb * 32, (bf16*)(wl + WO_DN), DFF, nb * 32, 1.0f, scr, lane); }
    }
    const int gt = gw * 64 + lane, NGT = NGW * 64;
    for (int it = gt; it < 2 * 4 * 8 * 1024; it += NGT) {
        const int e = it & 1023, cb = (it >> 10) & 7, g = (it >> 13) & 3, l = it >> 15;
        const float* wb = ap->in[I_WBR] + (size_t)l * 1280 * DM + (size_t)(g * 64) * DM + e;
        const float* ps = ap->in[I_POOLS] + l * 256 + g * 64;
        float wk[64];
#pragma unroll
        for (int k = 0; k < 64; ++k) wk[k] = wb[(size_t)k * DM] * ps[k];
        const float* pw = ap->in[I_POOLW] + (size_t)l * 16384 + (size_t)(g * 64 + cb * 8) * 64;
        float r8[8];
#pragma unroll
        for (int c = 0; c < 8; ++c) { float acc = 0.f;
#pragma unroll
            for (int k = 0; k < 64; ++k) acc += pw[c * 64 + k] * wk[k];
            r8[c] = acc; }
        u32x4 o; o.x = pk2(r8[0], r8[1]); o.y = pk2(r8[2], r8[3]); o.z = pk2(r8[4], r8[5]); o.w = pk2(r8[6], r8[7]);
        *(u32x4*)((bf16*)(ap->ws + WS_W + (size_t)l * W_LAYER + WO_BR0) + (size_t)e * 256 + g * 64 + cb * 8) = o;
    }
    float* rope = (float*)(ap->ws + WS_ROPE);
    for (int it = gt; it < SEQ * 32; it += NGT) {
        const int pos = it >> 5, i = it & 31;
        const float inv_freq = exp2f(-(float)i * (13.287712379549449f / 32.0f));
        const float ang = (float)pos * inv_freq;
        const double kq = rint((double)ang * 0.15915494309189535);
        const float red = (float)((double)ang - kq * 6.283185307179586);
        rope[it * 2] = cosf(red); rope[it * 2 + 1] = sinf(red);
    }
}

template <bool FL>
__device__ __forceinline__ void norm_phase(const float* x, const float* gain, bf16* H, const float* win_l, const float* b_forget, float* logf) {
    const int tid = tid_l(), lane = tid & 63, wave = __builtin_amdgcn_readfirstlane(tid >> 6), gw = blockIdx.x * NWAVES + wave, NGW = gridDim.x * NWAVES;
    f32x4 g[4];
#pragma unroll
    for (int j = 0; j < 4; ++j) g[j] = *(const f32x4*)(gain + 4 * lane + 256 * j);
    f32x4 wf[4][4];
    if (FL) {
#pragma unroll
        for (int j = 0; j < 4; ++j)
#pragma unroll
            for (int e = 0; e < 4; ++e) { const int col = 4 * lane + 256 * j + e; wf[j][e] = *(const f32x4*)(win_l + (size_t)col * DIN + 3328) * g[j][e]; }
    }
    f32x4 v[2][4];
#pragma unroll
    for (int u = 0; u < 2; ++u) { const f32x4* xr = (const f32x4*)(x + (size_t)(gw * 2 + u) * DM) + lane;
#pragma unroll
        for (int j = 0; j < 4; ++j) v[u][j] = xr[64 * j]; }
    for (int m0 = gw * 2; m0 < M; m0 += NGW * 2) {
        f32x4 vn[2][4];
        const int mn = (m0 + NGW * 2 < M) ? m0 + NGW * 2 : m0;
#pragma unroll
        for (int u = 0; u < 2; ++u) { const f32x4* xr = (const f32x4*)(x + (size_t)(mn + u) * DM) + lane;
#pragma unroll
            for (int j = 0; j < 4; ++j) vn[u][j] = xr[64 * j]; }
#pragma unroll
        for (int u = 0; u < 2; ++u) {
            const int m = m0 + u;
            float ss = 0.f;
#pragma unroll
            for (int j = 0; j < 4; ++j) ss += (v[u][j].x * v[u][j].x + v[u][j].y * v[u][j].y) + (v[u][j].z * v[u][j].z + v[u][j].w * v[u][j].w);
            ss = wave_sum(ss);
            const float rstd = 1.0f / sqrtf(ss * (1.0f / DM) + NORM_EPS);
            unsigned long long* o8 = (unsigned long long*)(H + (size_t)m * DM) + lane;
#pragma unroll
            for (int j = 0; j < 4; ++j) { const f32x4 t = v[u][j] * rstd * g[j]; o8[64 * j] = (unsigned long long)pk2(t.x, t.y) | ((unsigned long long)pk2(t.z, t.w) << 32); }
            if (FL) {
                f32x4 d = {0.f, 0.f, 0.f, 0.f};
#pragma unroll
                for (int j = 0; j < 4; ++j)
#pragma unroll
                    for (int e = 0; e < 4; ++e) d = d + wf[j][e] * v[u][j][e];
                d.x = wave_sum(d.x); d.y = wave_sum(d.y); d.z = wave_sum(d.z); d.w = wave_sum(d.w);
                if (lane < 4) {
                    const float dz = lane == 0 ? d.x : (lane == 1 ? d.y : (lane == 2 ? d.z : d.w));
                    const float z = dz * rstd + b_forget[lane];
                    logf[(size_t)m * 4 + lane] = fminf(z, 0.f) - log1pf(expf(-fabsf(z)));
                }
            }
        }
#pragma unroll
        for (int u = 0; u < 2; ++u)
#pragma unroll
            for (int j = 0; j < 4; ++j) v[u][j] = vn[u][j];
    }
}

__device__ __forceinline__ void e1_phase(int layer, LAS unsigned char* lds) {
    const ArgsP ap = get_args();
    const int tid = tid_l(), gt = blockIdx.x * 512 + tid, NGT = gridDim.x * 512;
    bf16* P = (bf16*)(ap->ws + WS_P);
    const float* rope = (const float*)(ap->ws + WS_ROPE);
    {
        const int lane = tid & 63, hvl = lane >> 3, ch = lane & 7;
        const int gwv = blockIdx.x * NWAVES + (tid >> 6), NGWV = gridDim.x * NWAVES;
        for (int it0 = gwv * 4; it0 < M * 3; it0 += NGWV * 4) {
            u32x4 wv[4];
#pragma unroll
            for (int u = 0; u < 4; ++u) { const int it = it0 + u, m = it / 3, seg = it - m * 3; const int col = seg == 0 ? C_DQ : (seg == 1 ? C_DK : C_FQ);
                wv[u] = *((const u32x4*)(P + (size_t)m * PW + col) + lane); }
#pragma unroll
            for (int u = 0; u < 4; ++u) {
                const int it = it0 + u, m = it / 3, seg = it - m * 3, pos = m & (SEQ - 1);
                const int col = seg == 0 ? C_DQ : (seg == 1 ? C_DK : C_FQ);
                const float* gn = seg == 0 ? ap->in[I_DQN] : (seg == 1 ? ap->in[I_DKN] : (hvl < 4 ? ap->in[I_FQN] : ap->in[I_FKN]));
                const float sc = seg == 0 ? C2 : (seg == 1 ? 1.0f : (hvl < 4 ? C2 : 1.0f));
                const u32x4 w = wv[u];
                float v[8] = {bflo(w.x), bfhi(w.x), bflo(w.y), bfhi(w.y), bflo(w.z), bfhi(w.z), bflo(w.w), bfhi(w.w)};
                float ss = 0.f;
#pragma unroll
                for (int j = 0; j < 8; ++j) ss += v[j] * v[j];
                ss += __shfl_xor(ss, 1); ss += __shfl_xor(ss, 2); ss += __shfl_xor(ss, 4);
                const float rs = 1.0f / sqrtf(ss * (1.0f / 64.0f) + NORM_EPS);
                const f32x4 g0 = *(const f32x4*)(gn + layer * 64 + ch * 8), g1 = *(const f32x4*)(gn + layer * 64 + ch * 8 + 4);
                v[0] *= rs * g0.x; v[1] *= rs * g0.y; v[2] *= rs * g0.z; v[3] *= rs * g0.w; v[4] *= rs * g1.x; v[5] *= rs * g1.y; v[6] *= rs * g1.z; v[7] *= rs * g1.w;
                if (seg < 2) {
                    const f32x4* rp = (const f32x4*)(rope + (size_t)pos * 64 + (ch & 3) * 16);
                    const float sgn = ch < 4 ? -1.0f : 1.0f;
#pragma unroll
                    for (int j = 0; j < 8; j += 2) { const f32x4 cs = rp[j >> 1];
                        const float p0 = __shfl_xor(v[j], 4), p1 = __shfl_xor(v[j + 1], 4);
                        v[j] = v[j] * cs.x + sgn * p0 * cs.y; v[j + 1] = v[j + 1] * cs.z + sgn * p1 * cs.w; }
                }
                u32x4 o; o.x = pk2(v[0] * sc, v[1] * sc); o.y = pk2(v[2] * sc, v[3] * sc); o.z = pk2(v[4] * sc, v[5] * sc); o.w = pk2(v[6] * sc, v[7] * sc);
                *((u32x4*)(P + (size_t)m * PW + col) + lane) = o;
            }
        }
    }
    bf16* POOL = (bf16*)(ap->ws + WS_POOL);
    for (int it = gt; it < M * 32; it += NGT) {
        const int m = it >> 5, ch = it & 31, pos = m & (SEQ - 1), g = ch >> 3, wnd = 2 << g;
        const int cnt = (pos + 1 < wnd) ? pos + 1 : wnd;
        u32x4 wl[16];
#pragma unroll
        for (int i = 0; i < 16; ++i) { wl[i] = (u32x4){0u, 0u, 0u, 0u}; if (i < cnt) wl[i] = *(const u32x4*)(P + (size_t)(m - i) * PW + ch * 8); }
        float s8[8];
#pragma unroll
        for (int j = 0; j < 8; ++j) s8[j] = 0.f;
#pragma unroll
        for (int i = 0; i < 16; ++i) { s8[0] += bflo(wl[i].x); s8[1] += bfhi(wl[i].x); s8[2] += bflo(wl[i].y); s8[3] += bfhi(wl[i].y); s8[4] += bflo(wl[i].z); s8[5] += bfhi(wl[i].z); s8[6] += bflo(wl[i].w); s8[7] += bfhi(wl[i].w); }
        const float inv = 1.0f / (float)cnt;
        const u32x4 w0 = wl[0];
        u32x4 o; o.x = pk2(s8[0] * inv - bflo(w0.x), s8[1] * inv - bfhi(w0.x)); o.y = pk2(s8[2] * inv - bflo(w0.y), s8[3] * inv - bfhi(w0.y));
        o.z = pk2(s8[4] * inv - bflo(w0.z), s8[5] * inv - bfhi(w0.z)); o.w = pk2(s8[6] * inv - bflo(w0.w), s8[7] * inv - bfhi(w0.w));
        *(u32x4*)(POOL + (size_t)m * 256 + ch * 8) = o;
    }
    if (blockIdx.x < 32) {
        const int bh = blockIdx.x, b = bh >> 2, h = bh & 3, lane = tid & 63, wave = tid >> 6;
        const float* lf = (const float*)(ap->ws + WS_LOGF) + (size_t)b * SEQ * 4 + h;
        float* cum = (float*)(ap->ws + WS_CUM) + (size_t)bh * SEQ;
        LAS float* wsum = (LAS float*)(lds + LDS_MISC + 64);
        float loc[16]; float run = 0.f;
#pragma unroll
        for (int i = 0; i < 16; ++i) { run += lf[(size_t)(tid * 16 + i) * 4]; loc[i] = run; }
        float inc = run;
#pragma unroll
        for (int o = 1; o < 64; o <<= 1) { const float t = __shfl_up(inc, o); if (lane >= o) inc += t; }
        if (lane == 63) wsum[wave] = inc;
        __syncthreads();
        float off = inc - run;
        for (int w2 = 0; w2 < wave; ++w2) off += wsum[w2];
#pragma unroll
        for (int i = 0; i < 16; ++i) cum[tid * 16 + i] = loc[i] + off;
        __syncthreads();
    }
}

constexpr int A_KS = 0, A_KS_SZ = 64 * 144, A_VT = 2 * A_KS_SZ, A_VT_SZ = 64 * 320, A_BIAS = A_VT + 2 * A_VT_SZ, A_FLAG = A_BIAS + 512, A_END = A_FLAG + 64;
static_assert(A_END <= LDS_MISC, "attention LDS");
__device__ __forceinline__ int crow(int r, int hi) { return (r & 3) + 8 * (r >> 2) + 4 * hi; }

template <int TYPE, int DV>
__device__ __forceinline__ void attn_pass(LAS unsigned char* lds, const bf16* Qrow, const bf16* Kb, const bf16* Vb, const float* cum, int q0, int NT, f32x16 (&o)[DV / 32], float& l_out, const float smax = 0.f) {
    const int tid = tid_l(), lane = tid & 63, r32 = lane & 31, hi = lane >> 5, wid = __builtin_amdgcn_readfirstlane(tid >> 6);
    const int qw = q0 + 32 * wid, qrow = qw + r32, kdiag = qw >> 6;
    bf16x8 qf[4];
#pragma unroll
    for (int d0 = 0; d0 < 4; ++d0) qf[d0] = *(const bf16x8*)(Qrow + d0 * 16 + hi * 8);
    const int skey = tid >> 3, sch = tid & 7;
    constexpr int VPITCH = (DV == 64) ? 192 : 320;
    const int vtoff = (4 * hi + ((lane >> 2) & 3)) * VPITCH + (((lane >> 4) & 1) * 16 + (lane & 3) * 4) * 2;
    const bf16* ksrc = Kb + (size_t)skey * PW + sch * 8;
    const bf16* vsrc = Vb + (size_t)skey * PW + sch * 8;
    const float cref = (TYPE == 2) ? cum[q0] : 0.f;
    u32x4 kreg, vreg[DV / 64]; float breg = 0.f;
    const int t_first = (TYPE != 0) ? NT - 1 : 0, step = (TYPE != 0) ? -1 : 1;
#define A_LOAD(kt) do { kreg = *(const u32x4*)(ksrc + (size_t)(kt) * 64 * PW); \
        _Pragma("unroll") for (int i_ = 0; i_ < DV / 64; ++i_) vreg[i_] = *(const u32x4*)(vsrc + (size_t)(kt) * 64 * PW + i_ * 64); \
        if (TYPE == 2 && tid < 64) breg = cum[(kt) * 64 + tid]; } while (0)
#define A_STORE(buf) do { *(LAS u32x4*)(lds + A_KS + (buf) * A_KS_SZ + skey * 144 + sch * 16) = kreg; \
        _Pragma("unroll") for (int i_ = 0; i_ < DV / 64; ++i_) *(LAS u32x4*)(lds + A_VT + (buf) * A_VT_SZ + skey * VPITCH + i_ * 128 + sch * 16) = vreg[i_]; \
        if (TYPE == 2 && tid < 64) *(LAS float*)(lds + A_BIAS + (buf) * 256 + tid * 4) = (cref - breg) * LOG2E; } while (0)
    A_LOAD(t_first); A_STORE(0); if (NT > 1) A_LOAD(t_first + step); __syncthreads();
    float m_run = 0.f, l_run = 0.f, R = 0.f;
    f32x16 negm;
#pragma unroll
    for (int r = 0; r < 16; ++r) negm[r] = 0.f;
    bool nomax = (TYPE == 0) && (smax <= 60.0f);
    bool fresh = !nomax;
    for (int it = 0; it < NT; ++it) {
        const int kt = t_first + step * it, buf = it & 1; const bool more = it + 1 < NT;
        if (more) { A_STORE(buf ^ 1); if (it + 2 < NT) A_LOAD(kt + 2 * step); }
        float bnext = 0.f;
        if (TYPE == 2 && kt > 0) bnext = (cref - cum[kt * 64 - 1]) * LOG2E;
        int wdone = 0;
        if (kt <= kdiag) {
            const LAS unsigned char* kp = lds + A_KS + buf * A_KS_SZ + r32 * 144 + hi * 16;
            const LAS unsigned char* vp = lds + A_VT + buf * A_VT_SZ + vtoff;
            bf16x8 kf[8];
#pragma unroll
            for (int d0 = 0; d0 < 4; ++d0) { kf[2 * d0] = *(const LAS bf16x8*)(kp + d0 * 32); kf[2 * d0 + 1] = *(const LAS bf16x8*)(kp + 32 * 144 + d0 * 32); }
            __builtin_amdgcn_sched_barrier(0);
            f32x16 s0, s1;
            if (TYPE == 1 || nomax) {
                const f32x16 zz = {0.f, 0.f, 0.f, 0.f, 0.f, 0.f, 0.f, 0.f, 0.f, 0.f, 0.f, 0.f, 0.f, 0.f, 0.f, 0.f};
                s0 = __builtin_amdgcn_mfma_f32_32x32x16_bf16(kf[0], qf[0], zz, 0, 0, 0);
                s1 = __builtin_amdgcn_mfma_f32_32x32x16_bf16(kf[1], qf[0], zz, 0, 0, 0);
            } else {
                s0 = __builtin_amdgcn_mfma_f32_32x32x16_bf16(kf[0], qf[0], negm, 0, 0, 0);
                s1 = __builtin_amdgcn_mfma_f32_32x32x16_bf16(kf[1], qf[0], negm, 0, 0, 0);
            }
#pragma unroll
            for (int d0 = 1; d0 < 4; ++d0) {
                s0 = __builtin_amdgcn_mfma_f32_32x32x16_bf16(kf[2 * d0], qf[d0], s0, 0, 0, 0);
                s1 = __builtin_amdgcn_mfma_f32_32x32x16_bf16(kf[2 * d0 + 1], qf[d0], s1, 0, 0, 0);
            }
            __builtin_amdgcn_sched_barrier(0);
            s16x4 vf[2][4][2];
#pragma unroll
            for (int dt = 0; dt < 2; ++dt)
#pragma unroll
                for (int c = 0; c < 4; ++c) {
                    vf[dt][c][0] = __builtin_amdgcn_ds_read_tr16_b64_v4i16((LAS s16x4*)(vp + (16 * c) * VPITCH + dt * 64));
                    vf[dt][c][1] = __builtin_amdgcn_ds_read_tr16_b64_v4i16((LAS s16x4*)(vp + (16 * c + 8) * VPITCH + dt * 64)); }
            __builtin_amdgcn_sched_barrier(0);
            if (TYPE == 2) {
                const LAS float* bp = (const LAS float*)(lds + A_BIAS + buf * 256) + 4 * hi;
#pragma unroll
                for (int g = 0; g < 4; ++g) { const f32x4 b0 = *(const LAS f32x4*)(bp + 8 * g), b1 = *(const LAS f32x4*)(bp + 32 + 8 * g);
#pragma unroll
                    for (int j = 0; j < 4; ++j) { s0[4 * g + j] += b0[j]; s1[4 * g + j] += b1[j]; } }
            }
            if (kt == kdiag) {
                const int kb = kt * 64 + 4 * hi, lim = (TYPE == 1) ? qrow - 1 : qrow;
#pragma unroll
                for (int r = 0; r < 16; ++r) { const int kv = kb + (r & 3) + 8 * (r >> 2); if (kv > lim) s0[r] = -INFINITY; if (kv + 32 > lim) s1[r] = -INFINITY; }
            }
            if (TYPE == 1) {
                f32x16 L0, L1;
#pragma unroll
                for (int r = 0; r < 16; ++r) {
                    const float z0 = fminf(s0[r], 80.0f), z1 = fminf(s1[r], 80.0f);
                    s0[r] = z0; s1[r] = z1;
                    L0[r] = -__builtin_amdgcn_logf(1.0f + __builtin_amdgcn_exp2f(z0));
                    L1[r] = -__builtin_amdgcn_logf(1.0f + __builtin_amdgcn_exp2f(z1));
                }
#define SB_G0(a) ((L0[4 * (a)] + L0[4 * (a) + 1]) + (L0[4 * (a) + 2] + L0[4 * (a) + 3]))
#define SB_G1(a) ((L1[4 * (a)] + L1[4 * (a) + 1]) + (L1[4 * (a) + 2] + L1[4 * (a) + 3]))
                const float T7 = SB_G1(3), T6 = SB_G1(2) + T7, T5 = SB_G1(1) + T6, T4 = SB_G1(0) + T5, T3 = SB_G0(3) + T4, T2 = SB_G0(2) + T3, T1 = SB_G0(1) + T2, T0 = SB_G0(0) + T1;
                const float P0 = partner32(T0), P1 = partner32(T1), P2 = partner32(T2), P3 = partner32(T3), P4 = partner32(T4), P5 = partner32(T5), P6 = partner32(T6), P7 = partner32(T7);
#define SB_APPLY(S, L, q, TN, PA, PB) do { float sf = R + (TN) + (hi ? (PB) : (PA)); \
                    S[(q) + 3] = __builtin_amdgcn_exp2f(S[(q) + 3] + L[(q) + 3] + sf); sf += L[(q) + 3]; \
                    S[(q) + 2] = __builtin_amdgcn_exp2f(S[(q) + 2] + L[(q) + 2] + sf); sf += L[(q) + 2]; \
                    S[(q) + 1] = __builtin_amdgcn_exp2f(S[(q) + 1] + L[(q) + 1] + sf); sf += L[(q) + 1]; \
                    S[(q)] = __builtin_amdgcn_exp2f(S[(q)] + L[(q)] + sf); } while (0)
                SB_APPLY(s0, L0, 0, T1, P0, P1); SB_APPLY(s0, L0, 4, T2, P1, P2); SB_APPLY(s0, L0, 8, T3, P2, P3); SB_APPLY(s0, L0, 12, T4, P3, P4);
                SB_APPLY(s1, L1, 0, T5, P4, P5); SB_APPLY(s1, L1, 4, T6, P5, P6); SB_APPLY(s1, L1, 8, T7, P6, P7); SB_APPLY(s1, L1, 12, 0.f, P7, 0.f);
#undef SB_G0
#undef SB_G1
#undef SB_APPLY
                R += T0 + P0;
            } else {
                float mx = 0.f;
                if (TYPE != 0 || !nomax) {
                asm volatile("s_nop 15\n\ts_nop 7" : "+v"(s0), "+v"(s1));
                float ma = max3f(s0[0], s0[1], s1[0]), mb = max3f(s0[2], s0[3], s1[1]);
                ma = max3f(ma, s1[2], s1[3]);
#pragma unroll
                for (int r = 4; r < 16; r += 4) { ma = max3f(ma, s0[r], s0[r + 1]); mb = max3f(mb, s0[r + 2], s0[r + 3]); ma = max3f(ma, s1[r], s1[r + 1]); mb = max3f(mb, s1[r + 2], s1[r + 3]); }
                mx = fmaxf(ma, mb);
                mx = fmaxf(mx, partner32(mx));
                }
                if (fresh || __any(mx > 8.0f)) {
                    const float dl = fresh ? mx : fmaxf(mx, 0.f);
                    m_run += dl;
#pragma unroll
                    for (int r = 0; r < 16; ++r) { s0[r] -= dl; s1[r] -= dl; negm[r] = -m_run; }
                    if (!fresh) {
                        const float alpha = __builtin_amdgcn_exp2f(-dl);
                        l_run *= alpha;
#pragma unroll
                        for (int dt = 0; dt < DV / 32; ++dt)
#pragma unroll
                            for (int r = 0; r < 16; ++r) o[dt][r] *= alpha;
                    }
                    fresh = false;
                    if (TYPE == 0) nomax = __all(m_run >= smax - 8.0f) != 0;
                }
#pragma unroll
                for (int r = 0; r < 16; ++r) { s0[r] = __builtin_amdgcn_exp2f(s0[r]); s1[r] = __builtin_amdgcn_exp2f(s1[r]); }
                asm volatile("s_nop 1" : "+v"(s0), "+v"(s1));
                float pa = s0[0], pb = s1[0], pc = s0[1], pd = s1[1];
#pragma unroll
                for (int r = 2; r < 16; r += 2) { pa = fadd_v(pa, s0[r]); pb = fadd_v(pb, s1[r]); pc = fadd_v(pc, s0[r + 1]); pd = fadd_v(pd, s1[r + 1]); }
                l_run += (pa + pb) + (pc + pd);
            }
            __builtin_amdgcn_sched_barrier(0);
            u32x4 pw[4];
            pw[0] = (u32x4){pk2(s0[0], s0[1]), pk2(s0[2], s0[3]), pk2(s0[4], s0[5]), pk2(s0[6], s0[7])};
            pw[1] = (u32x4){pk2(s0[8], s0[9]), pk2(s0[10], s0[11]), pk2(s0[12], s0[13]), pk2(s0[14], s0[15])};
            pw[2] = (u32x4){pk2(s1[0], s1[1]), pk2(s1[2], s1[3]), pk2(s1[4], s1[5]), pk2(s1[6], s1[7])};
            pw[3] = (u32x4){pk2(s1[8], s1[9]), pk2(s1[10], s1[11]), pk2(s1[12], s1[13]), pk2(s1[14], s1[15])};
#pragma unroll
            for (int dt = 0; dt < 2; ++dt)
#pragma unroll
                for (int c = 0; c < 4; ++c) {
                    const s16x4 lo = vf[dt][c][0], h2 = vf[dt][c][1];
                    const bf16x8 va = {lo[0], lo[1], lo[2], lo[3], h2[0], h2[1], h2[2], h2[3]};
                    o[dt] = __builtin_amdgcn_mfma_f32_32x32x16_bf16(va, __builtin_bit_cast(bf16x8, pw[c]), o[dt], 0, 0, 0);
                }
#pragma unroll
            for (int dt = 2; dt < DV / 32; ++dt)
#pragma unroll
                for (int c = 0; c < 4; ++c) {
                    const s16x4 lo = __builtin_amdgcn_ds_read_tr16_b64_v4i16((LAS s16x4*)(vp + (16 * c) * VPITCH + dt * 64));
                    const s16x4 h2 = __builtin_amdgcn_ds_read_tr16_b64_v4i16((LAS s16x4*)(vp + (16 * c + 8) * VPITCH + dt * 64));
                    const bf16x8 va = {lo[0], lo[1], lo[2], lo[3], h2[0], h2[1], h2[2], h2[3]};
                    o[dt] = __builtin_amdgcn_mfma_f32_32x32x16_bf16(va, __builtin_bit_cast(bf16x8, pw[c]), o[dt], 0, 0, 0);
                }
            if (TYPE == 1) wdone = __all(R < -160.0f) ? 1 : 0;
            if (TYPE == 2) wdone = (kt == 0 || __all(smax + bnext - m_run < -160.0f)) ? 1 : 0;
        }
        if (TYPE != 0 && lane == 0) *(LAS int*)(lds + A_FLAG + (buf * 8 + wid) * 4) = wdone;
        __syncthreads();
        if (TYPE != 0) {
            const u32x4 f0 = *(const LAS u32x4*)(lds + A_FLAG + buf * 32), f1 = *(const LAS u32x4*)(lds + A_FLAG + buf * 32 + 16);
            if ((f0.x & f0.y & f0.z & f0.w & f1.x & f1.y & f1.z & f1.w) != 0u) break;
        }
    }
    if (TYPE != 0) __syncthreads();
#undef A_LOAD
#undef A_STORE
    l_out = l_run + partner32(l_run);
}

template <int DV>
__device__ __forceinline__ void store_o(bf16* Orow, const f32x16 (&o)[DV / 32], int hi) {
#pragma unroll
    for (int dt = 0; dt < DV / 32; ++dt)
#pragma unroll
        for (int g = 0; g < 4; ++g) { u32x2 w; w.x = pk2(o[dt][4 * g], o[dt][4 * g + 1]); w.y = pk2(o[dt][4 * g + 2], o[dt][4 * g + 3]); *(u32x2*)(Orow + dt * 32 + 8 * g + 4 * hi) = w; }
}

__device__ __forceinline__ void attn_phase(int layer, LAS unsigned char* lds, const bool dry = false) {
    const ArgsP ap = get_args();
    const int tid = tid_l(), lane = tid & 63, r32 = lane & 31, hi = lane >> 5, wid = tid >> 6;
    bf16* P = (bf16*)(ap->ws + WS_P);
    unsigned* ctr = (unsigned*)(ap->ws + WS_CTL) + (layer + (dry ? 2 : 0)) * 8 * 64;
    const unsigned xcd0 = ((unsigned)__builtin_amdgcn_s_getreg((3 << 11) | 20) & 0xFu) & 7u;
    bf16* dummy = (bf16*)(ap->ws + WS_STASH + (size_t)blockIdx.x * STASH_BLK + 131072) + tid * 256;
    volatile LAS unsigned* ubox = (volatile LAS unsigned*)(lds + LDS_MISC);
    const float lambda_init = 0.8f - 0.6f * expf(-0.3f * (float)layer);
    float lam;
    {
        float d1 = 0.f, d2 = 0.f;
        for (int i = 0; i < 64; ++i) { d1 += ap->in[I_LQ1][layer * 64 + i] * ap->in[I_LK1][layer * 64 + i]; d2 += ap->in[I_LQ2][layer * 64 + i] * ap->in[I_LK2][layer * 64 + i]; }
        lam = expf(d1) - expf(d2) + lambda_init;
    }
    float fox_smax;
    {
        float gq = 0.f, gk = 0.f;
        for (int i = 0; i < 64; ++i) { gq = fmaxf(gq, fabsf(ap->in[I_FQN][layer * 64 + i])); gk = fmaxf(gk, fabsf(ap->in[I_FKN][layer * 64 + i])); }
        fox_smax = 64.0f * gq * gk * C2 * 1.02f;
    }
    float diff_smax;
    {
        float gq = 0.f, gk = 0.f;
        for (int i = 0; i < 64; ++i) { gq = fmaxf(gq, fabsf(ap->in[I_DQN][layer * 64 + i])); gk = fmaxf(gk, fabsf(ap->in[I_DKN][layer * 64 + i])); }
        diff_smax = 64.0f * gq * gk * C2 * 1.02f;
    }
    for (;;) {
        __syncthreads();
        if (tid == 0) {
            unsigned got = 0xffffffffu;
            for (unsigned a = 0; a < 8u; ++a) { const unsigned x = (xcd0 + a) & 7u;
                const unsigned j = __hip_atomic_fetch_add(ctr + x * 64, 1u, __ATOMIC_RELAXED, __HIP_MEMORY_SCOPE_AGENT);
                if (j < 384u) { got = x * 384u + j; break; } }
            ubox[0] = got;
        }
        __syncthreads();
        const unsigned u = ubox[0];
        if (u == 0xffffffffu) break;
        const int ux = (int)(u / 384u), uj = (int)(u % 384u), ut = uj >> 7, jj = uj & 127;
        const int type = ut == 0 ? 0 : (ut == 1 ? 2 : 1), bh = ux + 8 * (jj >> 5), qb = 31 - (jj & 31), b = bh >> 2, h = bh & 3;
        const int q0 = qb * 256, NT = 4 * qb + 4;
        const size_t rowbase = (size_t)b * SEQ;
        bf16* Pq = P + (rowbase + q0 + 32 * wid + r32) * PW;
        const bf16* Pk = P + rowbase * PW;
#ifndef TYM
#define TYM 7
#endif
        if ((TYM & 4) && type == 2) {
            f32x16 o[2];
#pragma unroll
            for (int r = 0; r < 16; ++r) { o[0][r] = 0.f; o[1][r] = 0.f; }
            float l;
            attn_pass<2, 64>(lds, Pq + C_FQ + h * 64, Pk + C_FK + h * 64, Pk + C_FV + h * 64, (const float*)(ap->ws + WS_CUM) + (size_t)bh * SEQ, q0, NT, o, l, fox_smax);
            const float inv = 1.0f / l;
#pragma unroll
            for (int r = 0; r < 16; ++r) { o[0][r] *= inv; o[1][r] *= inv; }
            store_o<64>(dry ? dummy : Pq + C_FQ + h * 64, o, hi);
        } else if ((TYM & 2) && type == 1) {
            f32x16 o[2];
#pragma unroll
            for (int r = 0; r < 16; ++r) { o[0][r] = 0.f; o[1][r] = 0.f; }
            float l;
            attn_pass<1, 64>(lds, Pq + C_SQ + h * 64, Pk + C_SK + h * 64, Pk + C_SV + h * 64, nullptr, q0, NT, o, l);
            store_o<64>(dry ? dummy : Pq + C_SQ + h * 64, o, hi);
        } else if (TYM & 1) {
            f32x16 o[4]; f32x4* o1s = (f32x4*)(ap->ws + WS_STASH + (size_t)blockIdx.x * STASH_BLK) + tid * 16;
#pragma unroll 1
            for (int mm = 0; mm < 2; ++mm) {
#pragma unroll
                for (int dt = 0; dt < 4; ++dt)
#pragma unroll
                    for (int r = 0; r < 16; ++r) o[dt][r] = 0.f;
                float l;
                attn_pass<0, 128>(lds, Pq + C_DQ + (h * 2 + mm) * 64, Pk + C_DK + (h * 2 + mm) * 64, Pk + C_DV + h * 128, nullptr, q0, NT, o, l, diff_smax);
                const float inv = 1.0f / l;
                if (mm == 0) {
#pragma unroll
                    for (int dt = 0; dt < 4; ++dt)
#pragma unroll
                        for (int g = 0; g < 4; ++g) o1s[dt * 4 + g] = (f32x4){o[dt][4 * g], o[dt][4 * g + 1], o[dt][4 * g + 2], o[dt][4 * g + 3]} * inv;
                } else {
                    float ss = 0.f;
#pragma unroll
                    for (int dt = 0; dt < 4; ++dt)
#pragma unroll
                        for (int g = 0; g < 4; ++g) { const f32x4 p1 = o1s[dt * 4 + g]; float q = 0.f;
#pragma unroll
                            for (int j = 0; j < 4; ++j) { const float c = p1[j] - lam * inv * o[dt][4 * g + j]; o[dt][4 * g + j] = c; q += c * c; }
                            ss += q; asm volatile("" : "+v"(ss) :: "memory"); }
                    ss += partner32(ss);
                    const float rn = (1.0f - lambda_init) / sqrtf(ss * (1.0f / 128.0f) + NORM_EPS);
                    const float* sg = ap->in[I_SUBLN] + layer * 128 + 4 * hi;
#pragma unroll
                    for (int dt = 0; dt < 4; ++dt)
#pragma unroll
                        for (int g = 0; g < 4; ++g) { const f32x4 gg = *(const f32x4*)(sg + dt * 32 + 8 * g);
#pragma unroll
                            for (int j = 0; j < 4; ++j) o[dt][4 * g + j] *= rn * gg[j];
                            if (g == 3) asm volatile("" ::: "memory"); }
                    store_o<128>(dry ? dummy : Pq + C_DQ + h * 128, o, hi);
                }
            }
        }
    }
}


#define XB_TMO      128
#define XB_XCNT(j)  (256  + 64 * (j))
#define XB_XSUB(j)  (1280 + 64 * (j))
#define XB_XGEN(j)  (2304 + 64 * (j))
#define XB_TOP      3328
#define XB_TOPGEN   3392
#define XCD_BAR_WORDS 3456
#define XB_SPIN_CAP (1u << 22)
__device__ __forceinline__ unsigned xb_ld(unsigned* p)              { return __hip_atomic_load(p, __ATOMIC_RELAXED, __HIP_MEMORY_SCOPE_AGENT); }
__device__ __forceinline__ unsigned xb_add(unsigned* p, unsigned v) { return __hip_atomic_fetch_add(p, v, __ATOMIC_RELAXED, __HIP_MEMORY_SCOPE_AGENT); }
__device__ __forceinline__ unsigned xb_xcc_id() { return (unsigned)__builtin_amdgcn_s_getreg((3 << 11) | 20) & 0xFu; }
#define XB_SPIN(cond, bar) do { unsigned _sp = 0; while (cond) { __builtin_amdgcn_s_sleep(1); \
    if ((++_sp & 255u) == 0u) { if (xb_ld(&(bar)[XB_TMO])) break; if (_sp > XB_SPIN_CAP) { atomicAdd(&(bar)[XB_TMO], 1u); break; } } } } while (0)
struct XcdBarrier { unsigned* bar; unsigned x; volatile LAS unsigned* st; };
__device__ __forceinline__ XcdBarrier xcd_barrier_post(unsigned* bar, volatile LAS unsigned* st) {
    XcdBarrier b; b.bar = bar; b.x = xb_xcc_id(); b.st = st;
    if (threadIdx.x == 0) (void)xb_add(&bar[XB_XCNT(b.x)], 1u);
    return b;
}
__device__ __forceinline__ void xcd_barrier_complete(unsigned* bar, unsigned x, unsigned& nloc, unsigned& nx) {
    const unsigned G = gridDim.x * gridDim.y * gridDim.z;
    unsigned sum, cnt, mine, sp = 0u;
    for (;;) {
        sum = 0u; cnt = 0u; mine = 0u;
#pragma unroll
        for (unsigned j = 0; j < 16; ++j) { const unsigned c = xb_ld(&bar[XB_XCNT(j)]); sum += c; cnt += (c > 0u) ? 1u : 0u; mine = (j == x) ? c : mine; }
        if (sum == G) break;
        __builtin_amdgcn_s_sleep(1);
        if ((++sp & 255u) == 0u) { if (xb_ld(&bar[XB_TMO])) break; if (sp > XB_SPIN_CAP) { atomicAdd(&bar[XB_TMO], 1u); break; } }
    }
    nloc = mine > 0u ? mine : 1u; nx = cnt > 0u ? cnt : 1u;
}
__device__ __forceinline__ void xcd_barrier(const XcdBarrier& b) {
    asm volatile("s_waitcnt vmcnt(0)" ::: "memory");
    __syncthreads();
    if (threadIdx.x == 0) {
        unsigned* bar = b.bar;
        __builtin_amdgcn_s_waitcnt(0);
        unsigned nloc = b.st[0], nx = b.st[1];
        if (nloc == 0u) { xcd_barrier_complete(bar, b.x, nloc, nx); b.st[0] = nloc; b.st[1] = nx; }
        const unsigned old = xb_add(&bar[XB_XSUB(b.x)], 1u);
        const unsigned gen = old / nloc;
        if (old + 1u == (gen + 1u) * nloc) {
            __builtin_amdgcn_fence(__ATOMIC_RELEASE, "agent");
            asm volatile("s_waitcnt vmcnt(0)" ::: "memory");
            const unsigned og = xb_add(&bar[XB_TOP], 1u);
            const unsigned tg = og / nx;
            if (og + 1u == (tg + 1u) * nx) xb_add(&bar[XB_TOPGEN], 1u);
            else XB_SPIN(xb_ld(&bar[XB_TOPGEN]) == tg, bar);
            __builtin_amdgcn_fence(__ATOMIC_ACQUIRE, "agent");
            xb_add(&bar[XB_XGEN(b.x)], 1u);
            asm volatile("s_waitcnt vmcnt(0)" ::: "memory");
        } else {
            XB_SPIN(xb_ld(&bar[XB_XGEN(b.x)]) == gen, bar);
            __builtin_amdgcn_fence(__ATOMIC_ACQUIRE, "agent");
            asm volatile("s_waitcnt vmcnt(0)" ::: "memory");
        }
    }
    __syncthreads();
}

#ifndef PH
#define PH 0xFFFF
#endif
__global__ void __launch_bounds__(512, 2) mega_fwd(Args a_unused) {
    extern __shared__ __attribute__((aligned(16))) unsigned char lds_raw[];
    LAS unsigned char* lds = (LAS unsigned char*)lds_raw;
    cg::grid_group grid = cg::this_grid();
    const int G = gridDim.x, bx = blockIdx.x;
    if (threadIdx.x < 8) ((volatile LAS unsigned*)(lds + LDS_MISC + 128))[threadIdx.x] = 0u;
    __syncthreads();
    const XcdBarrier xbar = xcd_barrier_post((unsigned*)(get_args()->ws + WS_CTL) + 4096, (volatile LAS unsigned*)(lds + LDS_MISC + 128));
#define GSYNC() xcd_barrier(xbar)

    if (PH & 1) prologue(lds);
#pragma unroll 1
    for (int layer = 0; layer < 2; ++layer) {
        if (PH & 2) { const ArgsP ap = get_args(); const float* xin = layer == 0 ? ap->in[I_X] : ap->out;
          norm_phase<true>(xin, ap->in[I_ANORM] + layer * DM, (bf16*)(ap->ws + WS_H), ap->in[I_WIN] + (size_t)layer * DM * DIN, ap->in[I_BFORGET] + layer * 4, (float*)(ap->ws + WS_LOGF)); }
        if (layer == 0) grid.sync(); else GSYNC();
        if (PH & 4) { const ArgsP ap = get_args(); unsigned char* ws = ap->ws; const unsigned char* wl = ws + WS_W + (size_t)layer * W_LAYER;
          pg8::SimpleSched S; S.A = (const char*)(ws + WS_H); S.B = (const char*)(wl + WO_IN); S.lda2 = 2048; S.ldb2 = 2048; S.nt = 16; S.ord.init(256, 13, G, bx);
          pg8::EpiStore E{(bf16*)(ws + WS_P), PW}; pg8::gemm_phase(lds, S, E); }
        GSYNC();
        if (PH & 8) e1_phase(layer, lds);
        GSYNC();
#ifdef DRY_ATTN
        attn_phase(layer, lds, true);
#endif
        if (PH & 16) attn_phase(layer, lds);
        GSYNC();
        if (PH & 32) { const ArgsP ap = get_args(); unsigned char* ws = ap->ws; const unsigned char* wl = ws + WS_W + (size_t)layer * W_LAYER;
          pg8::MergeSched S; S.H = (const char*)(ws + WS_H); S.P = (const char*)(ws + WS_P); S.POOL = (const char*)(ws + WS_POOL); S.wl = (const char*)wl;
          S.ord.init(256, 4, G, bx);
          pg8::EpiMerge E{ap->in[I_BGATE] + layer * 4 * DM, (u32x4*)(ws + WS_STASH + (size_t)bx * STASH_BLK), (bf16*)(ws + WS_MERGED)};
          pg8::gemm_phase(lds, S, E); }
        GSYNC();
        if (PH & 64) { const ArgsP ap = get_args(); unsigned char* ws = ap->ws; const unsigned char* wl = ws + WS_W + (size_t)layer * W_LAYER;
          pg8::SimpleSched S; S.A = (const char*)(ws + WS_MERGED); S.B = (const char*)(wl + WO_OUT); S.lda2 = 2048; S.ldb2 = 2048; S.nt = 16; S.ord.init(256, 4, G, bx);
          pg8::EpiResid E{layer == 0 ? ap->in[I_X] : ap->out, ap->out}; pg8::gemm_phase(lds, S, E); }
        GSYNC();
        if (PH & 128) { const ArgsP ap = get_args();
          norm_phase<false>(ap->out, ap->in[I_FNORM] + layer * DM, (bf16*)(ap->ws + WS_H), nullptr, nullptr, nullptr); }
        GSYNC();
        if (PH & 256) { const ArgsP ap = get_args(); unsigned char* ws = ap->ws; const unsigned char* wl = ws + WS_W + (size_t)layer * W_LAYER;
          pg8::SimpleSched S; S.A = (const char*)(ws + WS_H); S.B = (const char*)(wl + WO_UP); S.lda2 = 2048; S.ldb2 = 2048; S.nt = 16; S.ord.init(256, 22, G, bx);
          pg8::EpiSwiGLU E{(bf16*)(ws + WS_P)}; pg8::gemm_phase(lds, S, E); }
        GSYNC();
        if (PH & 512) { const ArgsP ap = get_args(); unsigned char* ws = ap->ws; const unsigned char* wl = ws + WS_W + (size_t)layer * W_LAYER;
          pg8::SimpleSched S; S.A = (const char*)(ws + WS_P); S.B = (const char*)(wl + WO_DN); S.lda2 = DFF * 2; S.ldb2 = DFF * 2; S.nt = DFF / 64; S.ord.init(256, 4, G, bx);
          pg8::EpiResid E{ap->out, ap->out}; pg8::gemm_phase(lds, S, E); }
        if (layer == 0) GSYNC();
    }
}

extern "C" void kernel_launch(void* const* d_in, const int* in_sizes, int n_in, void* d_out, int out_size, void* d_ws, size_t ws_size, hipStream_t stream) {
    static int grid = 0;
    if (grid == 0) {
        if (n_in != 21 || out_size != M * DM || ws_size < WS_END) { fprintf(stderr, "kernel_launch: unexpected shapes: n_in %d out %d ws %zu (need %zu)\n", n_in, out_size, ws_size, (size_t)WS_END); grid = -1; return; }
        int dev = 0, cus = 0, per = 0;
        (void)hipGetDevice(&dev); (void)hipDeviceGetAttribute(&cus, hipDeviceAttributeMultiprocessorCount, dev);
        (void)hipFuncSetAttribute((const void*)mega_fwd, hipFuncAttributeMaxDynamicSharedMemorySize, LDS_BYTES);
        (void)hipOccupancyMaxActiveBlocksPerMultiprocessor(&per, (const void*)mega_fwd, 512, LDS_BYTES);
        if (per < 1) fprintf(stderr, "kernel_launch: occupancy query says %d blocks/CU\n", per);
        (void)hipGetLastError();
        grid = cus;
    }
    if (grid < 0) return;
    (void)hipMemsetAsync(d_ws, 0, 65536, stream);
    Args a{};
    for (int i = 0; i < 21; ++i) a.in[i] = (const float*)d_in[i];
    a.out = (float*)d_out; a.ws = (unsigned char*)d_ws;
    void* args[] = {&a};
    hipError_t e = hipLaunchCooperativeKernel((const void*)mega_fwd, dim3(grid), dim3(512), args, LDS_BYTES, stream);
    if (e != hipSuccess) fprintf(stderr, "kernel_launch: cooperative launch failed: %s (grid %d)\n", hipGetErrorString(e), grid);
}
```
